# Optimizing an MI355X kernel written in HIP

```python
import jax, jax.numpy as jnp
from jax import lax
import numpy as np

D_MODEL = 1024
BATCH = 2
SEQ = 8192
DEPTH = 1

N_META = 16
D_MIX = D_MODEL
LRU_WIDTH = D_MIX // 2
LRU_HEADS = 8
LRU_HEAD_DIM = LRU_WIDTH // LRU_HEADS
LRU_CONV = 4
LRU_C = 8.0
MLA_HEADS = 8
QK_NOPE = 64
QK_ROPE = 32
QK_DIM = QK_NOPE + QK_ROPE
V_DIM = (D_MIX - LRU_WIDTH) // MLA_HEADS
Q_LORA = 256
KV_LORA = 128
ROPE_THETA = 10000.0
Q_BLOCK = 128
D_FF = 2816
FFN_CONV = 3
EPS = 1e-6
NEG_INF = -1e30
IN_COLS = 2 * LRU_WIDTH + Q_LORA + KV_LORA + QK_ROPE

kernel_name = "hymba_rglru_mla_convglu_encoder"


def rmsnorm(x, g):
    xf = x.astype(jnp.float32)
    y = xf * lax.rsqrt(jnp.mean(xf * xf, axis=-1, keepdims=True) + EPS)
    return (y * g.astype(jnp.float32)).astype(x.dtype)


def dwconv(x, w, b, left):
    K = w.shape[0]
    T = x.shape[1]
    xp = jnp.pad(x, ((0, 0), (left, K - 1 - left), (0, 0)))
    y = xp[:, 0:T] * w[0]
    for k in range(1, K):
        y = y + xp[:, k:k + T] * w[k]
    return y + b


def rope(x, pos):
    R = x.shape[-1]
    inv_freq = ROPE_THETA ** (-jnp.arange(0, R, 2, dtype=jnp.float32) / R)
    ang = pos[:, None] * inv_freq[None, :]
    cos = jnp.cos(ang)[:, None, :]
    sin = jnp.sin(ang)[:, None, :]
    xf = x.astype(jnp.float32)
    x1, x2 = xf[..., :R // 2], xf[..., R // 2:]
    out = jnp.concatenate([x1 * cos - x2 * sin, x1 * sin + x2 * cos], axis=-1)
    return out.astype(x.dtype)


def _lin_combine(left, right):
    a1, b1 = left
    a2, b2 = right
    return a1 * a2, a2 * b1 + b2


def rg_lru_bidir(xc, w_a, b_a, w_x, b_x, lam):
    B, T, W = xc.shape
    xf = xc.astype(jnp.float32)
    xh = xf.reshape(B, T, LRU_HEADS, LRU_HEAD_DIM)
    r = jax.nn.sigmoid(jnp.einsum('bthi,nhij->nbthj', xh, w_a.astype(jnp.float32)).reshape(2, B, T, W)
                       + b_a.astype(jnp.float32)[:, None, None, :])
    i = jax.nn.sigmoid(jnp.einsum('bthi,nhij->nbthj', xh, w_x.astype(jnp.float32)).reshape(2, B, T, W)
                       + b_x.astype(jnp.float32)[:, None, None, :])
    log_a = -LRU_C * r * jax.nn.softplus(-lam.astype(jnp.float32))[:, None, None, :]
    a = jnp.exp(log_a)
    u = jnp.sqrt(-jnp.expm1(2.0 * log_a)) * (i * xf[None])
    _, h_fwd = lax.associative_scan(_lin_combine, (a[0], u[0]), axis=1)
    _, h_bwd = lax.associative_scan(_lin_combine, (a[1], u[1]), axis=1, reverse=True)
    return (h_fwd + h_bwd).astype(xc.dtype)


def block_attention(q, k, v):
    B, T, H, Dk = q.shape
    n_blocks = -(-T // Q_BLOCK)
    T_pad = n_blocks * Q_BLOCK
    pad = ((0, 0), (0, T_pad - T), (0, 0), (0, 0))
    q, k, v = jnp.pad(q, pad), jnp.pad(k, pad), jnp.pad(v, pad)
    key_valid = jnp.arange(T_pad) < T
    scale = 1.0 / np.sqrt(Dk).astype(np.float32)
    qb = q.reshape(B, n_blocks, Q_BLOCK, H, Dk).transpose(1, 0, 2, 3, 4)

    def one_block(qblk):
        s = jnp.einsum('bqhd,bkhd->bhqk', qblk, k).astype(jnp.float32) * scale
        s = jnp.where(key_valid[None, None, None, :], s, NEG_INF)
        p = jax.nn.softmax(s, axis=-1).astype(v.dtype)
        return jnp.einsum('bhqk,bkhd->bqhd', p, v)

    o = lax.map(one_block, qb)
    o = o.transpose(1, 0, 2, 3, 4).reshape(B, T_pad, H, v.shape[-1])
    return o[:, :T]


def setup_inputs(seed: int = 0) -> dict:
    key = jax.random.key(seed)
    ks = jax.random.split(key, 32)
    f32 = jnp.float32

    def nrm(k, shape, fan_in):
        return jax.random.normal(k, shape, f32) * (fan_in ** -0.5)

    def gain(k, shape):
        return 1.0 + 0.02 * jax.random.normal(k, shape, f32)

    L = DEPTH
    a0 = jax.random.uniform(ks[10], (L, 2, LRU_WIDTH), f32, 0.9, 0.999)
    return {
        "x": jax.random.normal(ks[0], (BATCH, SEQ, D_MODEL), f32),
        "meta_tokens": jax.random.normal(ks[1], (N_META, D_MODEL), f32),
        "norm_mix_g": gain(ks[2], (L, D_MODEL)),
        "w_in": nrm(ks[3], (L, D_MODEL, IN_COLS), D_MODEL),
        "conv_lru_w": nrm(ks[4], (L, LRU_CONV, LRU_WIDTH), LRU_CONV),
        "conv_lru_b": 0.01 * jax.random.normal(ks[5], (L, LRU_WIDTH), f32),
        "lru_w_a": nrm(ks[6], (L, 2, LRU_HEADS, LRU_HEAD_DIM, LRU_HEAD_DIM), LRU_HEAD_DIM),
        "lru_b_a": 0.1 * jax.random.normal(ks[7], (L, 2, LRU_WIDTH), f32),
        "lru_w_x": nrm(ks[8], (L, 2, LRU_HEADS, LRU_HEAD_DIM, LRU_HEAD_DIM), LRU_HEAD_DIM),
        "lru_b_x": 0.1 * jax.random.normal(ks[9], (L, 2, LRU_WIDTH), f32),
        "lru_lambda": jnp.log(a0) - jnp.log1p(-a0),
        "lru_gate_g": gain(ks[11], (L, LRU_WIDTH)),
        "q_latent_g": gain(ks[12], (L, Q_LORA)),
        "w_uq": nrm(ks[13], (L, Q_LORA, MLA_HEADS * QK_DIM), Q_LORA),
        "kv_latent_g": gain(ks[14], (L, KV_LORA)),
        "w_ukv": nrm(ks[15], (L, KV_LORA, MLA_HEADS * (QK_NOPE + V_DIM)), KV_LORA),
        "q_norm_g": gain(ks[16], (L, QK_DIM)),
        "k_norm_g": gain(ks[17], (L, QK_DIM)),
        "mla_out_g": gain(ks[18], (L, MLA_HEADS * V_DIM)),
        "w_out": nrm(ks[19], (L, D_MIX, D_MODEL), D_MIX),
        "norm_ffn_g": gain(ks[20], (L, D_MODEL)),
        "w_ffn_up": nrm(ks[21], (L, D_MODEL, 2 * D_FF), D_MODEL),
        "conv_ffn_w": nrm(ks[22], (L, FFN_CONV, D_FF), FFN_CONV),
        "conv_ffn_b": 0.01 * jax.random.normal(ks[23], (L, D_FF), f32),
        "w_ffn_down": nrm(ks[24], (L, D_FF, D_MODEL), D_FF),
    }


def reference(x, meta_tokens, norm_mix_g, w_in, conv_lru_w, conv_lru_b, lru_w_a, lru_b_a,
              lru_w_x, lru_b_x, lru_lambda, lru_gate_g, q_latent_g, w_uq, kv_latent_g, w_ukv,
              q_norm_g, k_norm_g, mla_out_g, w_out, norm_ffn_g, w_ffn_up, conv_ffn_w,
              conv_ffn_b, w_ffn_down):
    B = x.shape[0]
    meta = jnp.broadcast_to(meta_tokens.astype(x.dtype)[None], (B, N_META, D_MODEL))
    h = jnp.concatenate([meta, x], axis=1)
    T = h.shape[1]
    pos = jnp.arange(T, dtype=jnp.float32)
    splits = np.cumsum([LRU_WIDTH, LRU_WIDTH, Q_LORA, KV_LORA]).tolist()

    for l in range(DEPTH):
        hn = rmsnorm(h, norm_mix_g[l])
        proj = hn @ w_in[l]
        x_lru, g_lru, c_q, c_kv, k_pe = jnp.split(proj, splits, axis=-1)

        xc = dwconv(x_lru, conv_lru_w[l], conv_lru_b[l], left=LRU_CONV // 2)
        y_lru = rg_lru_bidir(xc, lru_w_a[l], lru_b_a[l], lru_w_x[l], lru_b_x[l], lru_lambda[l])
        y_lru = y_lru * jax.nn.gelu(g_lru)

        q = (rmsnorm(c_q, q_latent_g[l]) @ w_uq[l]).reshape(B, T, MLA_HEADS, QK_DIM)
        kv = (rmsnorm(c_kv, kv_latent_g[l]) @ w_ukv[l]).reshape(B, T, MLA_HEADS, QK_NOPE + V_DIM)
        k_nope, v = kv[..., :QK_NOPE], kv[..., QK_NOPE:]
        k_rope = jnp.broadcast_to(k_pe[:, :, None, :], (B, T, MLA_HEADS, QK_ROPE))
        k = jnp.concatenate([k_nope, k_rope], axis=-1)
        q = rmsnorm(q, q_norm_g[l])
        k = rmsnorm(k, k_norm_g[l])
        q = jnp.concatenate([q[..., :QK_NOPE], rope(q[..., QK_NOPE:], pos)], axis=-1)
        k = jnp.concatenate([k[..., :QK_NOPE], rope(k[..., QK_NOPE:], pos)], axis=-1)
        y_mla = block_attention(q, k, v).reshape(B, T, MLA_HEADS * V_DIM)

        y = jnp.concatenate([rmsnorm(y_lru, lru_gate_g[l]), rmsnorm(y_mla, mla_out_g[l])], axis=-1)
        h = h + y @ w_out[l]

        hn = rmsnorm(h, norm_ffn_g[l])
        gate, up = jnp.split(hn @ w_ffn_up[l], 2, axis=-1)
        gate = dwconv(gate, conv_ffn_w[l], conv_ffn_b[l], left=FFN_CONV // 2)
        h = h + (jax.nn.silu(gate) * up) @ w_ffn_down[l]

    return h[:, N_META:]
```

```cpp
#include <hip/hip_runtime.h>
#include <cstdio>
#include <cstdint>

typedef unsigned short bf16_t;
typedef float f32x4 __attribute__((ext_vector_type(4)));
typedef unsigned u32x4 __attribute__((ext_vector_type(4)));
typedef unsigned u32x2 __attribute__((ext_vector_type(2)));

constexpr int NB = 2, SEQ = 8192, NMETA = 16, T = SEQ + NMETA, D = 1024;
constexpr int NR = NB * T;
constexpr int NRP = 16640;
constexpr int INC = 1440, PROJW = 1536, LW = 512, QL = 256, KVL = 128, RD = 32, NH = 8, QKD = 96, NOPE = 64, VD = 64, FF = 2816;
constexpr int TK = 8256, JOFF = 48;
constexpr float EPS = 1e-6f;

constexpr size_t MiB = 1u << 20;
constexpr size_t WS_CTL = 0;
constexpr size_t WS_ROPE = 1 * MiB;
constexpr size_t WS_SP = WS_ROPE + 1100 * 1024;
constexpr size_t WS_SSP = WS_SP + 8192;
constexpr size_t WS_H1B = 26 * MiB;
constexpr size_t WS_G = 59 * MiB;
constexpr size_t WS_U = WS_G + (size_t)NRP * FF * 2;
constexpr size_t WS_END_GU = WS_U + (size_t)NRP * FF * 2;
constexpr size_t WS_HN = 59 * MiB;
constexpr size_t WS_YN = 59 * MiB;
constexpr size_t WS_PROJ = 92 * MiB;
constexpr size_t WS_Q = 141 * MiB;
constexpr size_t WS_K = WS_Q + (size_t)NB * NH * TK * QKD * 2;
constexpr size_t WS_V = WS_K + (size_t)NB * NH * TK * QKD * 2;
constexpr size_t WS_V_END = WS_V + (size_t)NB * NH * TK * VD * 2;
constexpr size_t WS_YL = 208 * MiB;
constexpr size_t WS_XC = 92 * MiB + (size_t)NRP * PROJW * 2;
constexpr size_t WS_H1F = 92 * MiB;
static_assert(WS_V_END <= 208 * MiB, "qkv");
static_assert(WS_YL + (size_t)NR * LW * 4 <= 256 * MiB, "yl");
static_assert(WS_END_GU <= 240 * MiB, "gu");
static_assert(WS_SSP + 4 * NRP * 4 <= 26 * MiB, "ssp");

__device__ __forceinline__ float bf2f(bf16_t v) { return __uint_as_float((unsigned)v << 16); }
__device__ __forceinline__ unsigned f2bf(float f) { unsigned u = __float_as_uint(f); return (u + 0x7fffu + ((u >> 16) & 1u)) >> 16; }
__device__ __forceinline__ float wave_sum(float v) {
#pragma unroll
    for (int o = 1; o < 64; o <<= 1) v += __shfl_xor(v, o);
    return v;
}
__device__ __forceinline__ float sigmoidf_(float x) { return 1.f / (1.f + __expf(-x)); }
__device__ __forceinline__ float gelu_tanh(float x) {
    const float u = 0.7978845608028654f * (x + 0.044715f * x * x * x);
    const float e = __expf(2.f * u);
    const float th = 1.f - 2.f / (e + 1.f);
    return 0.5f * x * (1.f + th);
}

__device__ __forceinline__ void sincos_d(double x, double& s, double& c) {
    const double TWO_PI = 6.283185307179586476925286766559;
    const double n = rint(x / TWO_PI);
    const double r = x - n * TWO_PI;
    const double r2 = r * r;
    double ts = 1.0, tc = 1.0, ss = 1.0, cc = 1.0;
#pragma unroll 1
    for (int k = 1; k <= 15; ++k) {
        tc *= -r2 / (double)((2 * k - 1) * (2 * k)); cc += tc;
        ts *= -r2 / (double)((2 * k) * (2 * k + 1)); ss += ts;
    }
    s = r * ss; c = cc;
}
__global__ void k_tables(const float* __restrict__ lam, unsigned char* ws) {
    const int gid = blockIdx.x * blockDim.x + threadIdx.x, gsz = gridDim.x * blockDim.x;
    float2* rope = (float2*)(ws + WS_ROPE);
    for (int i = gid; i < T * 16; i += gsz) {
        const int t = i >> 4, j = i & 15;
        const float inv_freq = (float)exp2(-(double)j * (13.287712379549449 / 16.0));
        const float ang = (float)t * inv_freq;
        double s, c; sincos_d((double)ang, s, c);
        rope[i] = make_float2((float)c, (float)s);
    }
    float* sp = (float*)(ws + WS_SP);
    for (int i = gid; i < 2 * LW; i += gsz) sp[i] = (float)log1p(exp(-(double)lam[i]));
    bf16_t* Q = (bf16_t*)(ws + WS_Q); bf16_t* K = (bf16_t*)(ws + WS_K); bf16_t* V = (bf16_t*)(ws + WS_V);
    for (int i = gid; i < NB * NH * JOFF * QKD; i += gsz) { const int bh = i / (JOFF * QKD), r = i % (JOFF * QKD); Q[(size_t)bh * TK * QKD + r] = 0; K[(size_t)bh * TK * QKD + r] = 0; }
    for (int i = gid; i < NB * NH * JOFF * VD; i += gsz) { const int bh = i / (JOFF * VD), r = i % (JOFF * VD); V[(size_t)bh * TK * VD + r] = 0; }
}

__device__ __forceinline__ const float* h0_row(const float* x, const float* meta, int row) {
    const int b = row / T, t = row % T;
    return t < NMETA ? meta + (size_t)t * D : x + ((size_t)b * SEQ + (t - NMETA)) * D;
}
__global__ void k_hn(const float* __restrict__ x, const float* __restrict__ meta, const float* __restrict__ g, bf16_t* __restrict__ HN) {
    const int lane = threadIdx.x & 63, row = blockIdx.x * 4 + (threadIdx.x >> 6);
    if (row >= NRP) return;
    unsigned long long* o8 = (unsigned long long*)(HN + (size_t)row * D) + lane;
    if (row >= NR) { for (int j = 0; j < 4; ++j) o8[64 * j] = 0ull; return; }
    const f32x4* xr = (const f32x4*)h0_row(x, meta, row) + lane;
    f32x4 v[4]; float s = 0.f;
#pragma unroll
    for (int j = 0; j < 4; ++j) { v[j] = xr[64 * j]; s += v[j].x * v[j].x + v[j].y * v[j].y + v[j].z * v[j].z + v[j].w * v[j].w; }
    const float rstd = 1.f / sqrtf(wave_sum(s) * (1.f / D) + EPS);
#pragma unroll
    for (int j = 0; j < 4; ++j) { const f32x4 gg = ((const f32x4*)g)[lane + 64 * j];
        o8[64 * j] = (unsigned long long)(f2bf(v[j].x * rstd * gg.x) | (f2bf(v[j].y * rstd * gg.y) << 16)) | ((unsigned long long)(f2bf(v[j].z * rstd * gg.z) | (f2bf(v[j].w * rstd * gg.w) << 16)) << 32); }
}

template <class AF, class EF>
__global__ void __launch_bounds__(256) k_ngemm(int M, int N, int K, const float* __restrict__ W, AF af, EF ef) {
    __shared__ float As[16][68], Bs[16][68];
    const int tid = threadIdx.x, tx = tid & 15, ty = tid >> 4, row0 = blockIdx.y * 64, col0 = blockIdx.x * 64;
    float acc[4][4] = {};
    for (int k0 = 0; k0 < K; k0 += 16) {
#pragma unroll
        for (int i = 0; i < 4; ++i) { const int idx = tid + 256 * i, r = idx >> 4, k = idx & 15; As[k][r] = (row0 + r < M) ? af(row0 + r, k0 + k) : 0.f; }
#pragma unroll
        for (int i = 0; i < 4; ++i) { const int idx = tid + 256 * i, k = idx >> 6, c = idx & 63; Bs[k][c] = (col0 + c < N) ? W[(size_t)(k0 + k) * N + col0 + c] : 0.f; }
        __syncthreads();
#pragma unroll
        for (int k = 0; k < 16; ++k) {
            float a[4], b[4];
#pragma unroll
            for (int i = 0; i < 4; ++i) { a[i] = As[k][ty * 4 + i]; b[i] = Bs[k][tx * 4 + i]; }
#pragma unroll
            for (int i = 0; i < 4; ++i)
#pragma unroll
                for (int j = 0; j < 4; ++j) acc[i][j] += a[i] * b[j];
        }
        __syncthreads();
    }
#pragma unroll
    for (int i = 0; i < 4; ++i)
#pragma unroll
        for (int j = 0; j < 4; ++j) { const int r = row0 + ty * 4 + i, c = col0 + tx * 4 + j; if (r < M && c < N) ef(r, c, acc[i][j]); }
}
struct ABf16 { const bf16_t* A; long long lda; __device__ float operator()(int r, int k) const { return bf2f(A[(size_t)r * lda + k]); } };
struct ABf16G { const bf16_t* A; long long lda; const float* g; __device__ float operator()(int r, int k) const { return bf2f(A[(size_t)r * lda + k]) * g[k]; } };
struct EProj { bf16_t* C; __device__ void operator()(int r, int c, float v) const { C[(size_t)r * PROJW + c] = (bf16_t)f2bf(v); } };
struct EOut { const float* x; const float* meta; float* H1F; bf16_t* H1B; float* out;
    __device__ void operator()(int r, int c, float v) const {
        const float h1 = h0_row(x, meta, r)[c] + v; H1F[(size_t)r * D + c] = h1; H1B[(size_t)r * D + c] = (bf16_t)f2bf(h1);
        const int b = r / T, t = r % T; if (t >= NMETA) out[((size_t)b * SEQ + t - NMETA) * D + c] = h1; } };
struct EUp { const float* SSP; bf16_t* G; bf16_t* U;
    __device__ void operator()(int r, int c, float v) const {
        const float ss = (SSP[r] + SSP[NRP + r]) + (SSP[2 * NRP + r] + SSP[3 * NRP + r]); const float rstd = 1.f / sqrtf(ss * (1.f / D) + EPS); v *= rstd;
        if (c < FF) G[(size_t)r * FF + c] = (bf16_t)f2bf(v); else U[(size_t)r * FF + c - FF] = (bf16_t)f2bf(v); } };
struct EDown { float* out; __device__ void operator()(int r, int c, float v) const { const int b = r / T, t = r % T; if (t >= NMETA) out[((size_t)b * SEQ + t - NMETA) * D + c] += v; } };

__global__ void __launch_bounds__(256) k_mla(const bf16_t* __restrict__ PROJ, const float* __restrict__ gq_lat, const float* __restrict__ w_uq, const float* __restrict__ gkv_lat,
                                             const float* __restrict__ w_ukv, const float* __restrict__ gq, const float* __restrict__ gk, const float2* __restrict__ rope,
                                             bf16_t* __restrict__ Q, bf16_t* __restrict__ K, bf16_t* __restrict__ V) {
    __shared__ float cq[QL], ckv[KVL], kpe[RD], q[NH * QKD], kv[NH * 128], red[8], rs[16];
    const int row = blockIdx.x, tid = threadIdx.x, lane = tid & 63, wid = tid >> 6, b = row / T, t = row % T;
    const bf16_t* pr = PROJ + (size_t)row * PROJW;
    float v = bf2f(pr[1024 + tid]); float s = wave_sum(v * v); if (lane == 0) red[wid] = s;
    float v2 = 0.f; if (tid < KVL) v2 = bf2f(pr[1280 + tid]); float s2 = wave_sum(v2 * v2); if (lane == 0) red[4 + wid] = s2;
    if (tid < RD) kpe[tid] = bf2f(pr[1408 + tid]);
    __syncthreads();
    const float rq = 1.f / sqrtf((red[0] + red[1] + red[2] + red[3]) * (1.f / QL) + EPS), rkv = 1.f / sqrtf((red[4] + red[5]) * (1.f / KVL) + EPS);
    cq[tid] = v * rq * gq_lat[tid]; if (tid < KVL) ckv[tid] = v2 * rkv * gkv_lat[tid];
    __syncthreads();
    for (int n = tid; n < NH * QKD; n += 256) { float a = 0.f; for (int k = 0; k < QL; ++k) a += cq[k] * w_uq[(size_t)k * (NH * QKD) + n]; q[n] = a; }
    for (int n = tid; n < NH * 128; n += 256) { float a = 0.f; for (int k = 0; k < KVL; ++k) a += ckv[k] * w_ukv[(size_t)k * (NH * 128) + n]; kv[n] = a; }
    __syncthreads();
    if (tid < 16) { const int h = tid & 7; float ss = 0.f;
        if (tid < 8) { for (int d = 0; d < QKD; ++d) ss += q[h * QKD + d] * q[h * QKD + d]; }
        else { for (int d = 0; d < NOPE; ++d) ss += kv[h * 128 + d] * kv[h * 128 + d]; for (int d = 0; d < RD; ++d) ss += kpe[d] * kpe[d]; }
        rs[tid] = 1.f / sqrtf(ss * (1.f / QKD) + EPS); }
    __syncthreads();
    const size_t j = (size_t)t + JOFF;
    for (int n = tid; n < NH * QKD; n += 256) { const int h = n / QKD, d = n % QKD; const size_t o = (((size_t)b * NH + h) * TK + j) * QKD + d;
        float qv, kvv;
        if (d < NOPE) { qv = q[n] * rs[h] * gq[d]; kvv = kv[h * 128 + d] * rs[8 + h] * gk[d]; }
        else { const int i = (d - NOPE) & 15; const float2 cs = rope[t * 16 + i];
            const float q1 = q[h * QKD + NOPE + i] * rs[h] * gq[NOPE + i], q2 = q[h * QKD + NOPE + 16 + i] * rs[h] * gq[NOPE + 16 + i];
            const float k1 = kpe[i] * rs[8 + h] * gk[NOPE + i], k2 = kpe[16 + i] * rs[8 + h] * gk[NOPE + 16 + i];
            if (d - NOPE < 16) { qv = q1 * cs.x - q2 * cs.y; kvv = k1 * cs.x - k2 * cs.y; } else { qv = q1 * cs.y + q2 * cs.x; kvv = k1 * cs.y + k2 * cs.x; } }
        Q[o] = (bf16_t)f2bf(qv); K[o] = (bf16_t)f2bf(kvv); }
    for (int n = tid; n < NH * VD; n += 256) { const int h = n / VD, d = n % VD; V[(((size_t)b * NH + h) * TK + j) * VD + d] = (bf16_t)f2bf(kv[h * 128 + NOPE + d]); }
}

__global__ void __launch_bounds__(64) k_lru(const bf16_t* __restrict__ PROJ, const float* __restrict__ cw, const float* __restrict__ cb, const float* __restrict__ w_a, const float* __restrict__ b_a,
                                            const float* __restrict__ w_x, const float* __restrict__ b_x, const float* __restrict__ sp, float* __restrict__ YL, int dir) {
    __shared__ float xs[64];
    const int j = threadIdx.x, h = blockIdx.x & 7, b = blockIdx.x >> 3, c = h * 64 + j;
    float wa[64], wx[64];
#pragma unroll
    for (int i = 0; i < 64; ++i) { wa[i] = w_a[(((size_t)dir * NH + h) * 64 + i) * 64 + j]; wx[i] = w_x[(((size_t)dir * NH + h) * 64 + i) * 64 + j]; }
    const float ba = b_a[dir * LW + c], bx = b_x[dir * LW + c], spc = sp[dir * LW + c];
    const float w0 = cw[c], w1 = cw[LW + c], w2 = cw[2 * LW + c], w3 = cw[3 * LW + c], bc = cb[c];
    float hs = 0.f;
    for (int s = 0; s < T; ++s) {
        const int t = dir ? T - 1 - s : s; const size_t row = (size_t)b * T + t;
        float xc = bc + w2 * bf2f(PROJ[row * PROJW + c]);
        if (t >= 2) xc += w0 * bf2f(PROJ[(row - 2) * PROJW + c]);
        if (t >= 1) xc += w1 * bf2f(PROJ[(row - 1) * PROJW + c]);
        if (t + 1 < T) xc += w3 * bf2f(PROJ[(row + 1) * PROJW + c]);
        __syncthreads(); xs[j] = xc; __syncthreads();
        float ra = ba, ri = bx;
#pragma unroll
        for (int i = 0; i < 64; ++i) { ra += xs[i] * wa[i]; ri += xs[i] * wx[i]; }
        const float r = sigmoidf_(ra), ig = sigmoidf_(ri), la = -8.f * r * spc, a = __expf(la), u = sqrtf(fmaxf(1.f - __expf(2.f * la), 0.f)) * ig * xc;
        hs = a * hs + u;
        if (dir == 0) YL[row * LW + c] = hs; else YL[row * LW + c] += hs;
    }
}
__global__ void k_lru_out(const float* __restrict__ YL, const bf16_t* __restrict__ PROJ, const float* __restrict__ g, bf16_t* __restrict__ YN) {
    const int lane = threadIdx.x & 63, row = blockIdx.x * 4 + (threadIdx.x >> 6); if (row >= NR) return;
    float y[8]; float s = 0.f;
#pragma unroll
    for (int i = 0; i < 8; ++i) { const int c = lane + 64 * i; y[i] = YL[(size_t)row * LW + c] * gelu_tanh(bf2f(PROJ[(size_t)row * PROJW + LW + c])); s += y[i] * y[i]; }
    const float rstd = 1.f / sqrtf(wave_sum(s) * (1.f / LW) + EPS);
#pragma unroll
    for (int i = 0; i < 8; ++i) { const int c = lane + 64 * i; YN[(size_t)row * D + c] = (bf16_t)f2bf(y[i] * rstd * g[c]); }
}

__global__ void __launch_bounds__(256) k_attn(const bf16_t* __restrict__ Q, const bf16_t* __restrict__ K, const bf16_t* __restrict__ V, bf16_t* __restrict__ YN) {
    __shared__ float Ks[64][QKD], Vs[64][VD];
    const int bh = blockIdx.y, b = bh >> 3, h = bh & 7, tid = threadIdx.x, t = blockIdx.x * 256 + tid; const bool valid = t < T;
    const size_t base = (size_t)bh * TK;
    float q[QKD], o[VD];
    { const bf16_t* qp = Q + (base + (valid ? t : 0) + JOFF) * QKD;
#pragma unroll
      for (int d = 0; d < QKD; ++d) q[d] = bf2f(qp[d]) * 0.10206207261596575f; }
#pragma unroll
    for (int d = 0; d < VD; ++d) o[d] = 0.f;
    float m = -1e30f, l = 0.f;
    for (int j0 = 0; j0 < TK; j0 += 64) {
        __syncthreads();
        for (int i = tid; i < 64 * QKD; i += 256) Ks[i / QKD][i % QKD] = bf2f(K[(base + j0) * QKD + i]);
        for (int i = tid; i < 64 * VD; i += 256) Vs[i / VD][i % VD] = bf2f(V[(base + j0) * VD + i]);
        __syncthreads();
        for (int jj = (j0 == 0 ? JOFF : 0); jj < 64; ++jj) {
            float s = 0.f;
#pragma unroll
            for (int d = 0; d < QKD; ++d) s += q[d] * Ks[jj][d];
            if (s > m) { const float f = __expf(m - s); l *= f;
#pragma unroll
                for (int d = 0; d < VD; ++d) o[d] *= f;
                m = s; }
            const float p = __expf(s - m); l += p;
#pragma unroll
            for (int d = 0; d < VD; ++d) o[d] += p * Vs[jj][d];
        }
    }
    if (valid) { const float il = 1.f / l; bf16_t* op = YN + ((size_t)b * T + t) * D + LW + h * VD;
#pragma unroll
        for (int d = 0; d < VD; ++d) op[d] = (bf16_t)f2bf(o[d] * il); }
}
__global__ void k_onorm(bf16_t* __restrict__ YN, const float* __restrict__ g) {
    const int lane = threadIdx.x & 63, row = blockIdx.x * 4 + (threadIdx.x >> 6); if (row >= NR) return;
    float y[8]; float s = 0.f; bf16_t* p = YN + (size_t)row * D + LW;
#pragma unroll
    for (int i = 0; i < 8; ++i) { y[i] = bf2f(p[lane + 64 * i]); s += y[i] * y[i]; }
    const float rstd = 1.f / sqrtf(wave_sum(s) * (1.f / LW) + EPS);
#pragma unroll
    for (int i = 0; i < 8; ++i) p[lane + 64 * i] = (bf16_t)f2bf(y[i] * rstd * g[lane + 64 * i]);
}
__global__ void k_ssp(const float* __restrict__ H1F, float* __restrict__ SSP) {
    const int lane = threadIdx.x & 63, row = blockIdx.x * 4 + (threadIdx.x >> 6); if (row >= NRP) return;
    float s = 0.f;
    if (row < NR) { for (int i = 0; i < 16; ++i) { const float v = H1F[(size_t)row * D + lane + 64 * i]; s += v * v; } s = wave_sum(s); }
    if (lane == 0) { SSP[row] = s; SSP[NRP + row] = 0.f; SSP[2 * NRP + row] = 0.f; SSP[3 * NRP + row] = 0.f; }
}
__global__ void k_act(const bf16_t* __restrict__ G, bf16_t* __restrict__ U, const float* __restrict__ cw, const float* __restrict__ cb) {
    const size_t idx = (size_t)blockIdx.x * 256 + threadIdx.x; const int c8 = (int)(idx % (FF / 8)); const size_t row = idx / (FF / 8); if (row >= NR) return;
    const int t = (int)(row % T), c = c8 * 8; if (t < NMETA) return;
    const u32x4 z = {0u, 0u, 0u, 0u};
    const u32x4 g0 = *(const u32x4*)(G + (row - 1) * FF + c), g1 = *(const u32x4*)(G + row * FF + c), g2 = (t + 1 < T) ? *(const u32x4*)(G + (row + 1) * FF + c) : z, uu = *(const u32x4*)(U + row * FF + c);
    u32x4 o;
#pragma unroll
    for (int i = 0; i < 4; ++i) { float r[2];
#pragma unroll
        for (int hh = 0; hh < 2; ++hh) { const int ch = c + 2 * i + hh; const unsigned sh = hh * 16;
            const float a0 = bf2f((bf16_t)(g0[i] >> sh)), a1 = bf2f((bf16_t)(g1[i] >> sh)), a2 = bf2f((bf16_t)(g2[i] >> sh)), up = bf2f((bf16_t)(uu[i] >> sh));
            const float gt = cw[ch] * a0 + cw[FF + ch] * a1 + cw[2 * FF + ch] * a2 + cb[ch];
            r[hh] = gt / (1.f + __expf(-gt)) * up; }
        o[i] = f2bf(r[0]) | (f2bf(r[1]) << 16); }
    *(u32x4*)(U + row * FF + c) = o;
}

extern "C" void kernel_launch(void* const* d_in, const int* in_sizes, int n_in, void* d_out, int out_size, void* d_ws, size_t ws_size, hipStream_t stream) {
    if (n_in != 25 || in_sizes[0] != NB * SEQ * D || out_size != NB * SEQ * D || ws_size < 256 * MiB) { fprintf(stderr, "kernel_launch: unexpected shapes n_in %d in0 %d out %d ws %zu\n", n_in, n_in > 0 ? in_sizes[0] : -1, out_size, ws_size); return; }
    const float* x = (const float*)d_in[0]; const float* meta = (const float*)d_in[1]; const float* g_mix = (const float*)d_in[2]; const float* w_in = (const float*)d_in[3];
    const float* cw_lru = (const float*)d_in[4]; const float* cb_lru = (const float*)d_in[5]; const float* w_a = (const float*)d_in[6]; const float* b_a = (const float*)d_in[7];
    const float* w_x = (const float*)d_in[8]; const float* b_x = (const float*)d_in[9]; const float* lam = (const float*)d_in[10]; const float* g_lru = (const float*)d_in[11];
    const float* g_qlat = (const float*)d_in[12]; const float* w_uq = (const float*)d_in[13]; const float* g_kvlat = (const float*)d_in[14]; const float* w_ukv = (const float*)d_in[15];
    const float* g_q = (const float*)d_in[16]; const float* g_k = (const float*)d_in[17]; const float* g_mla = (const float*)d_in[18]; const float* w_out = (const float*)d_in[19];
    const float* g_ffn = (const float*)d_in[20]; const float* w_up = (const float*)d_in[21]; const float* cw_ffn = (const float*)d_in[22]; const float* cb_ffn = (const float*)d_in[23];
    const float* w_down = (const float*)d_in[24];
    unsigned char* ws = (unsigned char*)d_ws; float* out = (float*)d_out;
    bf16_t* HN = (bf16_t*)(ws + WS_HN); bf16_t* PROJ = (bf16_t*)(ws + WS_PROJ); bf16_t* Q = (bf16_t*)(ws + WS_Q); bf16_t* K = (bf16_t*)(ws + WS_K); bf16_t* V = (bf16_t*)(ws + WS_V);
    bf16_t* YN = (bf16_t*)(ws + WS_YN); bf16_t* H1B = (bf16_t*)(ws + WS_H1B); bf16_t* G = (bf16_t*)(ws + WS_G); bf16_t* U = (bf16_t*)(ws + WS_U);
    float* YL = (float*)(ws + WS_YL); float* H1F = (float*)(ws + WS_H1F); float* SSP = (float*)(ws + WS_SSP); float* SP = (float*)(ws + WS_SP); float2* ROPE = (float2*)(ws + WS_ROPE);

    hipLaunchKernelGGL(k_tables, dim3(256), dim3(256), 0, stream, lam, ws);
    hipLaunchKernelGGL(k_hn, dim3(NRP / 4), dim3(256), 0, stream, x, meta, g_mix, HN);
    hipLaunchKernelGGL((k_ngemm<ABf16, EProj>), dim3((INC + 63) / 64, (NR + 63) / 64), dim3(256), 0, stream, NR, INC, D, w_in, ABf16{HN, D}, EProj{PROJ});
    hipLaunchKernelGGL(k_mla, dim3(NR), dim3(256), 0, stream, PROJ, g_qlat, w_uq, g_kvlat, w_ukv, g_q, g_k, ROPE, Q, K, V);
    hipLaunchKernelGGL(k_lru, dim3(NB * NH), dim3(64), 0, stream, PROJ, cw_lru, cb_lru, w_a, b_a, w_x, b_x, SP, YL, 0);
    hipLaunchKernelGGL(k_lru, dim3(NB * NH), dim3(64), 0, stream, PROJ, cw_lru, cb_lru, w_a, b_a, w_x, b_x, SP, YL, 1);
    hipLaunchKernelGGL(k_lru_out, dim3((NR + 3) / 4), dim3(256), 0, stream, YL, PROJ, g_lru, YN);
    hipLaunchKernelGGL(k_attn, dim3((T + 255) / 256, NB * NH), dim3(256), 0, stream, Q, K, V, YN);
    hipLaunchKernelGGL(k_onorm, dim3((NR + 3) / 4), dim3(256), 0, stream, YN, g_mla);
    hipLaunchKernelGGL((k_ngemm<ABf16, EOut>), dim3(D / 64, (NR + 63) / 64), dim3(256), 0, stream, NR, D, D, w_out, ABf16{YN, D}, EOut{x, meta, H1F, H1B, out});
    hipLaunchKernelGGL(k_ssp, dim3(NRP / 4), dim3(256), 0, stream, H1F, SSP);
    hipLaunchKernelGGL((k_ngemm<ABf16G, EUp>), dim3(2 * FF / 64, (NR + 63) / 64), dim3(256), 0, stream, NR, 2 * FF, D, w_up, ABf16G{H1B, D, g_ffn}, EUp{SSP, G, U});
    hipLaunchKernelGGL(k_act, dim3((unsigned)(((size_t)NR * (FF / 8) + 255) / 256)), dim3(256), 0, stream, G, U, cw_ffn, cb_ffn);
    hipLaunchKernelGGL((k_ngemm<ABf16, EDown>), dim3(D / 64, (NR + 63) / 64), dim3(256), 0, stream, NR, D, FF, w_down, ABf16{U, FF}, EDown{out});
}
```

```cpp
#include <hip/hip_runtime.h>
#include <cstdio>
#include <cstdint>

typedef unsigned short bf16_t;
typedef float f32x4 __attribute__((ext_vector_type(4)));
typedef unsigned u32x4 __attribute__((ext_vector_type(4)));
typedef unsigned u32x2 __attribute__((ext_vector_type(2)));

constexpr int NB = 2, SEQ = 8192, NMETA = 16, T = SEQ + NMETA, D = 1024;
constexpr int NR = NB * T;
constexpr int NRP = 16640;
constexpr int INC = 1440, PROJW = 1536, LW = 512, QL = 256, KVL = 128, RD = 32, NH = 8, QKD = 96, NOPE = 64, VD = 64, FF = 2816;
constexpr int TK = 8256, JOFF = 48;
constexpr float EPS = 1e-6f;

constexpr size_t MiB = 1u << 20;
constexpr size_t WS_CTL = 0, CTL_ZERO_BYTES = 32768;
constexpr size_t WS_ROPE = 1 * MiB;
constexpr size_t WS_SP = WS_ROPE + 1100 * 1024;
constexpr size_t WS_SSP = WS_SP + 8192;
constexpr size_t WS_WIN = 4 * MiB;
constexpr size_t WS_WUQ = 7 * MiB;
constexpr size_t WS_WUKV = 7 * MiB + 512 * 1024;
constexpr size_t WS_WL = 7 * MiB + 768 * 1024;
constexpr size_t WS_WOUT = 8 * MiB;
constexpr size_t WS_WUP = 10 * MiB;
constexpr size_t WS_WDN = 21 * MiB;
constexpr size_t WS_H1B = 27 * MiB;
constexpr size_t WS_G = 60 * MiB;
constexpr size_t WS_U = WS_G + (size_t)NRP * FF * 2;
constexpr size_t WS_END_GU = WS_U + (size_t)NRP * FF * 2;
constexpr size_t WS_HN = 60 * MiB;
constexpr size_t WS_YN = 60 * MiB;
constexpr size_t WS_PROJ = 93 * MiB;
constexpr size_t WS_Q = 142 * MiB;
constexpr size_t WS_K = WS_Q + (size_t)NB * NH * TK * QKD * 2;
constexpr size_t WS_V = WS_K + (size_t)NB * NH * TK * QKD * 2;
constexpr size_t WS_V_END = WS_V + (size_t)NB * NH * TK * VD * 2;
constexpr size_t WS_YL = 208 * MiB;
static_assert(WS_WDN + (size_t)D * FF * 2 <= WS_H1B && WS_H1B + (size_t)NRP * D * 2 <= WS_G, "weights/h1b");
static_assert(WS_HN + (size_t)NRP * D * 2 <= WS_PROJ && WS_PROJ + (size_t)NRP * PROJW * 2 <= WS_Q, "hn/proj");
static_assert(WS_V_END <= 208 * MiB, "qkv");
static_assert(WS_YL + (size_t)NR * LW * 4 <= 256 * MiB, "yl");
static_assert(WS_END_GU <= 240 * MiB, "gu");
static_assert(WS_SSP + 4 * NRP * 4 <= 4 * MiB, "ssp");

__device__ __forceinline__ float bf2f(bf16_t v) { return __uint_as_float((unsigned)v << 16); }
typedef float f32x2_t __attribute__((ext_vector_type(2))); typedef __bf16 bf16x2_t __attribute__((ext_vector_type(2)));
__device__ __forceinline__ unsigned pk2(float lo, float hi) { f32x2_t v = {lo, hi}; bf16x2_t b = __builtin_convertvector(v, bf16x2_t); return __builtin_bit_cast(unsigned, b); }
__device__ __forceinline__ unsigned f2bf(float f) { return pk2(f, 0.f) & 0xffffu; }
__device__ __forceinline__ float fexp(float x) { return __builtin_amdgcn_exp2f(x * 1.4426950408889634f); }
__device__ __forceinline__ float frcp(float x) { return __builtin_amdgcn_rcpf(x); }
__device__ __forceinline__ float wave_sum(float v) {
#pragma unroll
    for (int o = 1; o < 64; o <<= 1) v += __shfl_xor(v, o);
    return v;
}
__device__ __forceinline__ float gelu_tanh(float x) {
    const float u2 = -2.302208198f * (x + 0.044715f * x * x * x);
    return x * __builtin_amdgcn_rcpf(1.f + __builtin_amdgcn_exp2f(u2));
}
__device__ __forceinline__ void sincos_d(double x, double& s, double& c) {
    const double n = rint(x * 0.15915494309189533576888), r = fma(n, -6.283185307179586476925286766559, x), r2 = r * r;
    double cc = -3.76998762881590539e-33, ss = -1.21612504155351811e-34;
    cc = fma(cc, r2, 3.27988923706983776e-30); ss = fma(ss, r2, 1.13099628864477181e-31);
    cc = fma(cc, r2, -2.47959626322479723e-27); ss = fma(ss, r2, -9.18368986379554601e-29);
    cc = fma(cc, r2, 1.61173757109611839e-24); ss = fma(ss, r2, 6.44695028438447359e-26);
    cc = fma(cc, r2, -8.89679139245057408e-22); ss = fma(ss, r2, -3.86817017063068354e-23);
    cc = fma(cc, r2, 4.11031762331216484e-19); ss = fma(ss, r2, 1.95729410633912626e-20);
    cc = fma(cc, r2, -1.56192069685862253e-16); ss = fma(ss, r2, -8.22063524662432950e-18);
    cc = fma(cc, r2, 4.77947733238738525e-14); ss = fma(ss, r2, 2.81145725434552060e-15);
    cc = fma(cc, r2, -1.14707455977297245e-11); ss = fma(ss, r2, -7.64716373181981641e-13);
    cc = fma(cc, r2, 2.08767569878681002e-09); ss = fma(ss, r2, 1.60590438368216133e-10);
    cc = fma(cc, r2, -2.75573192239858883e-07); ss = fma(ss, r2, -2.50521083854417202e-08);
    cc = fma(cc, r2, 2.48015873015873016e-05); ss = fma(ss, r2, 2.75573192239858925e-06);
    cc = fma(cc, r2, -1.38888888888888894e-03); ss = fma(ss, r2, -1.98412698412698413e-04);
    cc = fma(cc, r2, 4.16666666666666644e-02); ss = fma(ss, r2, 8.33333333333333322e-03);
    cc = fma(cc, r2, -5.00000000000000000e-01); ss = fma(ss, r2, -1.66666666666666657e-01);
    c = fma(cc, r2, 1.0); s = r * fma(ss, r2, 1.0);
}
__device__ __forceinline__ float rope_inv_freq(int j) {
    constexpr float T16[16] = {1.000000000e+00f, 5.623413324e-01f, 3.162277639e-01f, 1.778279394e-01f, 1.000000015e-01f, 5.623413250e-02f, 3.162277490e-02f, 1.778279431e-02f, 9.999999776e-03f, 5.623413250e-03f, 3.162277630e-03f, 1.778279431e-03f, 1.000000047e-03f, 5.623413017e-04f, 3.162277571e-04f, 1.778279402e-04f};
    float v = T16[0];
#pragma unroll
    for (int i = 1; i < 16; ++i) v = (j == i) ? T16[i] : v;
    return v;
}
__device__ __forceinline__ const float* h0_row(const float* x, const float* meta, int row) {
    const int b = row / T, t = row % T;
    return t < NMETA ? meta + (size_t)t * D : x + ((size_t)b * SEQ + (t - NMETA)) * D;
}
namespace pg8 {
#define PG8_LAS __attribute__((address_space(3)))
typedef unsigned short bf16_t;
typedef short bf16x8 __attribute__((ext_vector_type(8)));
typedef float f32x4 __attribute__((ext_vector_type(4)));
typedef unsigned u32x4 __attribute__((ext_vector_type(4)));
constexpr int BM = 256, BK = 64, HALF = 128, HTB = HALF * BK * 2  , STAGE_BYTES = 8 * HTB, NXCD = 8, WGM = 8;

__host__ __device__ __forceinline__ int lds_byte(int r, int c) { const int st = (r >> 4) * 2 + (c >> 5), rr = r & 15, cc = c & 31, ob = rr * 64 + cc * 2; return st * 1024 + (ob ^ (((ob >> 9) & 1) << 5)); }
__host__ __device__ __forceinline__ void stage_rc(int b, int& R, int& C) { const int st = b / 1024, sb = b % 1024, swz = sb ^ (((sb >> 9) & 1) << 5); R = (st >> 1) * 16 + swz / 64; C = (st & 1) * 32 + (swz % 64) / 2; }
__host__ __device__ __forceinline__ int perm32(int rho) { const int n = rho >> 4, i = rho & 15; return 8 * (i >> 2) + 4 * n + (i & 3); }

struct Unit { int pm, pn; };
struct Gemm { const bf16_t* A; const bf16_t* Bt; int M, N, K; int rowmode; };
__host__ __device__ __forceinline__ size_t tile_row0(int rowmode, int pm) { return rowmode ? (size_t)(pm >> 5) * 8208 + 16 + (size_t)(pm & 31) * 256 : (size_t)pm * 256; }

struct StaticOrder {
    int nM, nN, nwg, G, c;
    __host__ __device__ void init(int M, int N, int G_, int c_) { nM = M / BM; nN = N / BM; nwg = nM * nN; G = G_; c = c_; }
    __host__ __device__ bool next(int i, Unit& u) const {
        const long L = (long)i * G + c; if (L >= nwg) return false;
        int wgid = (int)L; { const int q = nwg / NXCD, r = nwg % NXCD, xcd = wgid % NXCD, off = wgid / NXCD; wgid = (xcd < r ? xcd * (q + 1) : r * (q + 1) + (xcd - r) * q) + off; }
        const int nig = WGM * nN, gid = wgid / nig, fm = gid * WGM, gsz = (nM - fm) < WGM ? (nM - fm) : WGM;
        u.pm = fm + ((wgid % nig) % gsz); u.pn = (wgid % nig) / gsz; return true;
    }
    __device__ __forceinline__ void a_ready(const Unit&) const {}
    __device__ __forceinline__ void done(const Unit&) const {}
};

__device__ __forceinline__ unsigned cvt_pk_bf16(float lo, float hi) { unsigned r; asm volatile("v_cvt_pk_bf16_f32 %0, %1, %2" : "=v"(r) : "v"(lo), "v"(hi)); return r; }
typedef float f32x2 __attribute__((ext_vector_type(2)));
__device__ __forceinline__ f32x2 gelu_pk(f32x2 v) {
    const f32x2 av = __builtin_elementwise_abs(v), d = av * 0.2316418882f + 1.0f;
    f32x2 t; t.x = __builtin_amdgcn_rcpf(d.x); t.y = __builtin_amdgcn_rcpf(d.y);
    f32x2 q = t * 0.5307027145f + (-0.7265760135f); q = q * t + 0.7107068705f; q = q * t + (-0.142248368f); q = q * t + 0.127414796f; q = q * t;
    const f32x2 s = (v * v) * (-0.72134752044f);
    f32x2 e; e.x = __builtin_amdgcn_exp2f(s.x); e.y = __builtin_amdgcn_exp2f(s.y);
    const f32x2 m = v * (q * e), r = v - m;
    f32x2 o; o.x = v.x < 0.f ? m.x : r.x; o.y = v.y < 0.f ? m.y : r.y; return o;
}

template <int ACT  > struct EpiBf16 {
    static constexpr bool PERM = true, AFTER_DRAIN = false; static_assert(ACT == 0 || ACT == 1, "EpiBf16: ACT is 0 (none) or 1 (gelu_pk)");
    bf16_t* O; int ldc; const float* bias; int split_cols; size_t split_stride; float scale0;
    __device__ __forceinline__ void operator()(const f32x4 (&acc)[2][2][4][2], const Unit& u, int wr, int wc, int fr, int fq) const {
        const int row0 = u.pm * BM + wr * 64 + fr; int colt = u.pn * BM; bf16_t* base = O;
        float sc = 1.f; if (split_cols) { const int t = colt / split_cols; base += (size_t)t * split_stride; colt -= t * split_cols; if (t == 0) sc = scale0; }
        const int col0 = colt + wc * 32 + 8 * fq, bcol0 = u.pn * BM + wc * 32 + 8 * fq;
        f32x4 bv[2][2];
#pragma unroll
        for (int bj = 0; bj < 2; ++bj)
#pragma unroll
            for (int n = 0; n < 2; ++n) bv[bj][n] = bias ? *(const f32x4*)(bias + bcol0 + bj * HALF + 4 * n) : (f32x4){0.f, 0.f, 0.f, 0.f};
#pragma unroll
        for (int ai = 0; ai < 2; ++ai)
#pragma unroll
            for (int m = 0; m < 4; ++m) { bf16_t* rowp = base + (size_t)(row0 + ai * HALF + m * 16) * ldc + col0;
#pragma unroll
                for (int bj = 0; bj < 2; ++bj) { f32x4 v0 = acc[ai][bj][m][0] + bv[bj][0], v1 = acc[ai][bj][m][1] + bv[bj][1];
                    if (ACT == 1) { f32x2 a = gelu_pk((f32x2){v0[0], v0[1]}), b = gelu_pk((f32x2){v0[2], v0[3]}), c = gelu_pk((f32x2){v1[0], v1[1]}), d = gelu_pk((f32x2){v1[2], v1[3]});
                        v0 = (f32x4){a.x, a.y, b.x, b.y}; v1 = (f32x4){c.x, c.y, d.x, d.y}; }
                    v0 = v0 * sc; v1 = v1 * sc; u32x4 w; w.x = cvt_pk_bf16(v0[0], v0[1]); w.y = cvt_pk_bf16(v0[2], v0[3]); w.z = cvt_pk_bf16(v1[0], v1[1]); w.w = cvt_pk_bf16(v1[2], v1[3]);
                    *(u32x4*)(rowp + bj * HALF) = w; } }
    }
};


template <class Epi, class Sched, bool ALIGN_EPI = false, bool SP2 = false>
__device__ __forceinline__ void gemm_phase(PG8_LAS unsigned char* lds, const Gemm g, const Sched& S, const Epi& E) {
    const int tid = threadIdx.x, wid = __builtin_amdgcn_readfirstlane(tid >> 6), lane = tid & 63, wr = wid >> 2, wc = wid & 3, fr = lane & 15, fq = lane >> 4;
    const int K = g.K, nt = K / BK;
    unsigned voffA[2], voffB[2];
#pragma unroll
    for (int i = 0; i < 2; ++i) { int R, C; stage_rc(tid * 16 + i * 8192, R, C); const int Rb = Epi::PERM ? ((R & ~31) + perm32(R & 31)) : R;
        voffA[i] = (unsigned)(R * K + C) * 2u; voffB[i] = (unsigned)(Rb * K + C) * 2u; }
    const size_t kstep = (size_t)(BK * 2);
    const size_t hstep = (size_t)HALF * K * 2;
    const size_t tstep = 2 * hstep;
    const unsigned ldsw = (unsigned)wid * 1024u;
    const int aoff = lds_byte(wr * 64 + fr, fq * 8), boff = lds_byte(wc * 32 + fr, fq * 8);
#define PG8_SA(b, h) (((b) * 2 + (h)) * HTB)
#define PG8_SB(b, h) ((4 + (b) * 2 + (h)) * HTB)
#define PG8_STAGE(bufoff, gbase, voff) do { _Pragma("unroll") for (int _i = 0; _i < 2; ++_i) \
        __builtin_amdgcn_global_load_lds((const unsigned*)((const char*)(gbase) + (voff)[_i]), (PG8_LAS unsigned*)(lds + (bufoff) + ldsw + _i * 8192), 16, 0, 0); } while (0)
#define PG8_LDA(dst, b, h) do { _Pragma("unroll") for (int m = 0; m < 4; ++m) _Pragma("unroll") for (int k = 0; k < 2; ++k) dst[m][k] = *(const PG8_LAS bf16x8*)(lds + PG8_SA(b, h) + aoff + m * 2048 + k * 1024); } while (0)
#define PG8_LDB(dst, b, h) do { _Pragma("unroll") for (int n = 0; n < 2; ++n) _Pragma("unroll") for (int k = 0; k < 2; ++k) dst[n][k] = *(const PG8_LAS bf16x8*)(lds + PG8_SB(b, h) + boff + n * 2048 + k * 1024); } while (0)
#define PG8_MMA(ai, bj, At, Bt) do { __builtin_amdgcn_s_setprio(1); _Pragma("unroll") for (int m = 0; m < 4; ++m) _Pragma("unroll") for (int n = 0; n < 2; ++n) _Pragma("unroll") for (int k = 0; k < 2; ++k) \
        acc[ai][bj][m][n] = __builtin_amdgcn_mfma_f32_16x16x32_bf16(Bt[n][k], At[m][k], acc[ai][bj][m][n], 0, 0, 0); __builtin_amdgcn_s_setprio(0); } while (0)
#define PG8_WAIT_V(n) asm volatile("s_waitcnt vmcnt(" #n ")" ::: "memory")
#define PG8_WAIT_L(n) asm volatile("s_waitcnt lgkmcnt(" #n ")" ::: "memory")
#define PG8_BAR __builtin_amdgcn_s_barrier()
#define PG8_SCHED __builtin_amdgcn_sched_barrier(0)
    Unit cur, nxt; int ui = 0;
    if (!S.next(0, cur)) return;
    f32x4 acc[2][2][4][2];
#pragma unroll
    for (int a = 0; a < 2; ++a)
#pragma unroll
        for (int b = 0; b < 2; ++b)
#pragma unroll
            for (int m = 0; m < 4; ++m)
#pragma unroll
                for (int n = 0; n < 2; ++n) acc[a][b][m][n] = (f32x4){0.f, 0.f, 0.f, 0.f};
    bf16x8 At[4][2], B0[2][2], B1[2][2];
    const size_t rstep = (size_t)K * 2;
    const char* cA = (const char*)g.A + tile_row0(g.rowmode, cur.pm) * rstep; const char* cB = (const char*)g.Bt + (size_t)cur.pn * tstep;
    S.a_ready(cur);
    if constexpr (SP2) {
        PG8_STAGE(PG8_SB(0, 0), cB, voffB); PG8_STAGE(PG8_SB(0, 1), cB + hstep, voffB); PG8_STAGE(PG8_SA(0, 0), cA, voffA); PG8_STAGE(PG8_SA(0, 1), cA + hstep, voffA);
        if (wr == 1) PG8_BAR;
        PG8_WAIT_V(2); PG8_BAR;
        PG8_STAGE(PG8_SB(1, 0), cB + kstep, voffB); PG8_STAGE(PG8_SA(1, 0), cA + kstep, voffA); PG8_STAGE(PG8_SB(1, 1), cB + hstep + kstep, voffB);
        PG8_WAIT_V(6); PG8_BAR;
    } else {
        PG8_STAGE(PG8_SB(0, 0), cB, voffB); PG8_STAGE(PG8_SA(0, 0), cA, voffA); PG8_STAGE(PG8_SB(0, 1), cB + hstep, voffB); PG8_STAGE(PG8_SA(0, 1), cA + hstep, voffA);
        if (wr == 1) PG8_BAR;
        PG8_WAIT_V(4); PG8_BAR;
        PG8_STAGE(PG8_SB(1, 0), cB + kstep, voffB); PG8_STAGE(PG8_SA(1, 0), cA + kstep, voffA); PG8_STAGE(PG8_SB(1, 1), cB + hstep + kstep, voffB);
        PG8_WAIT_V(6); PG8_BAR;
    }
    for (;;) {
        const bool has_next = S.next(ui + 1, nxt);
        const char* nA = has_next ? (const char*)g.A + tile_row0(g.rowmode, nxt.pm) * rstep : cA; const char* nB = has_next ? (const char*)g.Bt + (size_t)nxt.pn * tstep : cB;
        for (int t = 0; t < nt; t += 2) {
            const bool last = (t == nt - 2);
            const char* a1 = cA + (size_t)(t + 1) * kstep;
            const char* a2 = last ? nA : cA + (size_t)(t + 2) * kstep; const char* b2 = last ? nB : cB + (size_t)(t + 2) * kstep;
            const char* a3 = a2 + kstep; const char* b3 = b2 + kstep;
            if (last && has_next) S.a_ready(nxt);
            if constexpr (SP2) {
            PG8_LDB(B0, 0, 0); PG8_LDB(B1, 0, 1); PG8_SCHED; PG8_LDA(At, 0, 0); PG8_STAGE(PG8_SA(1, 1), a1 + hstep, voffA);
            PG8_WAIT_V(8); PG8_WAIT_L(0); PG8_BAR; PG8_MMA(0, 0, At, B0); PG8_MMA(0, 1, At, B1); PG8_BAR; PG8_SCHED;
            PG8_LDA(At, 0, 1); PG8_STAGE(PG8_SB(0, 0), b2, voffB); PG8_STAGE(PG8_SB(0, 1), b2 + hstep, voffB); PG8_STAGE(PG8_SA(0, 0), a2, voffA);
            PG8_WAIT_V(8); PG8_WAIT_L(0); PG8_BAR; PG8_MMA(1, 0, At, B0); PG8_MMA(1, 1, At, B1); PG8_BAR; PG8_SCHED;
            PG8_LDB(B0, 1, 0); PG8_LDB(B1, 1, 1); PG8_SCHED; PG8_LDA(At, 1, 0); PG8_STAGE(PG8_SA(0, 1), a2 + hstep, voffA);
            PG8_WAIT_V(8); PG8_WAIT_L(0); PG8_BAR; PG8_MMA(0, 0, At, B0); PG8_MMA(0, 1, At, B1); PG8_BAR; PG8_SCHED;
            PG8_LDA(At, 1, 1); PG8_STAGE(PG8_SB(1, 0), b3, voffB); PG8_STAGE(PG8_SB(1, 1), b3 + hstep, voffB); PG8_STAGE(PG8_SA(1, 0), a3, voffA);
            PG8_WAIT_V(8); PG8_WAIT_L(0); PG8_BAR; PG8_MMA(1, 0, At, B0); PG8_MMA(1, 1, At, B1); PG8_BAR; PG8_SCHED;
            } else {
            PG8_LDB(B0, 0, 0); PG8_SCHED; PG8_LDA(At, 0, 0); PG8_STAGE(PG8_SA(1, 1), a1 + hstep, voffA);
            PG8_WAIT_L(8); PG8_BAR; PG8_WAIT_L(0); PG8_MMA(0, 0, At, B0); PG8_BAR; PG8_SCHED;
            PG8_LDB(B1, 0, 1); PG8_STAGE(PG8_SB(0, 0), b2, voffB);
            PG8_BAR; PG8_WAIT_L(0); PG8_MMA(0, 1, At, B1); PG8_BAR;
            PG8_LDA(At, 0, 1); PG8_STAGE(PG8_SA(0, 0), a2, voffA);
            PG8_BAR; PG8_WAIT_L(0); PG8_MMA(1, 0, At, B0); PG8_BAR; PG8_SCHED;
            PG8_STAGE(PG8_SB(0, 1), b2 + hstep, voffB);
            PG8_WAIT_V(6); PG8_BAR; PG8_MMA(1, 1, At, B1); PG8_BAR;
            PG8_LDB(B0, 1, 0); PG8_SCHED; PG8_LDA(At, 1, 0); PG8_STAGE(PG8_SA(0, 1), a2 + hstep, voffA);
            PG8_WAIT_L(8); PG8_BAR; PG8_WAIT_L(0); PG8_MMA(0, 0, At, B0); PG8_BAR; PG8_SCHED;
            PG8_LDB(B1, 1, 1); PG8_STAGE(PG8_SB(1, 0), b3, voffB);
            PG8_BAR; PG8_WAIT_L(0); PG8_MMA(0, 1, At, B1); PG8_BAR;
            PG8_LDA(At, 1, 1); PG8_STAGE(PG8_SA(1, 0), a3, voffA);
            PG8_BAR; PG8_WAIT_L(0); PG8_MMA(1, 0, At, B0); PG8_BAR; PG8_SCHED;
            PG8_STAGE(PG8_SB(1, 1), b3 + hstep, voffB);
            PG8_WAIT_V(6); PG8_BAR; PG8_MMA(1, 1, At, B1); PG8_BAR;
            }
        }
        if constexpr (ALIGN_EPI) { if (wr == 0) PG8_BAR; }
        if constexpr (!Epi::AFTER_DRAIN) { E(acc, cur, wr, wc, fr, fq); S.done(cur); }
        if (!has_next) break;
#pragma unroll
        for (int a = 0; a < 2; ++a)
#pragma unroll
            for (int b = 0; b < 2; ++b)
#pragma unroll
                for (int m = 0; m < 4; ++m)
#pragma unroll
                    for (int n = 0; n < 2; ++n) acc[a][b][m][n] = (f32x4){0.f, 0.f, 0.f, 0.f};
        cur = nxt; cA = nA; cB = nB; ++ui;
        if constexpr (ALIGN_EPI) { if (wr == 1) PG8_BAR; }
    }
    PG8_WAIT_V(0);
    if constexpr (!ALIGN_EPI) { if (wr == 0) PG8_BAR; }
    PG8_BAR;
    if constexpr (Epi::AFTER_DRAIN) { E.fused(acc, cur, wr, wc, fr, fq, lds, wid, lane); S.done(cur); }
#undef PG8_SA
#undef PG8_SB
#undef PG8_STAGE
#undef PG8_LDA
#undef PG8_LDB
#undef PG8_MMA
#undef PG8_WAIT_V
#undef PG8_WAIT_L
#undef PG8_BAR
#undef PG8_SCHED
}
}
#ifndef PG8_SP2
#define PG8_SP2 true
#endif
#ifndef PG8_ALIGN
#define PG8_ALIGN true
#endif
#define GAS __attribute__((address_space(1)))
#define LAS __attribute__((address_space(3)))
typedef unsigned short bf16;
typedef unsigned v4u __attribute__((ext_vector_type(4)));
typedef float f32x4 __attribute__((ext_vector_type(4)));
typedef short bf16x8 __attribute__((ext_vector_type(8)));
typedef GAS unsigned gu32;
typedef GAS unsigned long long gu64;
#define RLX_AGENT __ATOMIC_RELAXED, __HIP_MEMORY_SCOPE_AGENT
#define LDS_WAIT() asm volatile("s_waitcnt lgkmcnt(0)" ::: "memory")
#define VM_WAIT() asm volatile("s_waitcnt vmcnt(0)" ::: "memory")
__device__ __forceinline__ unsigned long long rt() { return __builtin_amdgcn_s_memrealtime(); }

#define XB_TMO      128
#define XB_XCNT(j)  (256  + 64 * (j))
#define XB_XSUB(j)  (1280 + 64 * (j))
#define XB_XGEN(j)  (2304 + 64 * (j))
#define XB_TOP      3328
#define XB_TOPGEN   3392
#define XCD_BAR_WORDS 3456
#define XB_SPIN_CAP (1u << 18)

__device__ __forceinline__ unsigned xb_ld(unsigned* p)              { return __hip_atomic_load(p, __ATOMIC_RELAXED, __HIP_MEMORY_SCOPE_AGENT); }
__device__ __forceinline__ unsigned xb_add(unsigned* p, unsigned v) { return __hip_atomic_fetch_add(p, v, __ATOMIC_RELAXED, __HIP_MEMORY_SCOPE_AGENT); }
__device__ __forceinline__ unsigned xb_xcc_id() { return (unsigned)__builtin_amdgcn_s_getreg((3 << 11) | 20) & 0xFu; }
#define XB_SPIN(cond, bar) do { unsigned _sp = 0; while (cond) { __builtin_amdgcn_s_sleep(1); \
    if ((++_sp & 255u) == 0u) { if (xb_ld(&(bar)[XB_TMO])) break; if (_sp > XB_SPIN_CAP) { atomicAdd(&(bar)[XB_TMO], 1u); break; } } } } while (0)

struct XcdBarrier {
    unsigned* bar; unsigned x;
    volatile LAS unsigned* st;
};

__device__ __forceinline__ XcdBarrier xcd_barrier_post(unsigned* bar, volatile LAS unsigned* st) {
    XcdBarrier b; b.bar = bar; b.x = xb_xcc_id(); b.st = st;
    if (threadIdx.x == 0) (void)xb_add(&bar[XB_XCNT(b.x)], 1u);
    return b;
}
__device__ __forceinline__ void xcd_barrier_complete(unsigned* bar, unsigned x, unsigned& nloc, unsigned& nx) {
    const unsigned G = gridDim.x * gridDim.y * gridDim.z;
    unsigned sum, cnt, mine, sp = 0u;
    for (;;) {
        sum = 0u; cnt = 0u; mine = 0u;
#pragma unroll
        for (unsigned j = 0; j < 16; ++j) { const unsigned c = xb_ld(&bar[XB_XCNT(j)]); sum += c; cnt += (c > 0u) ? 1u : 0u; mine = (j == x) ? c : mine; }
        if (sum == G) break;
        __builtin_amdgcn_s_sleep(1);
        if ((++sp & 255u) == 0u) { if (xb_ld(&bar[XB_TMO])) break; if (sp > XB_SPIN_CAP) { atomicAdd(&bar[XB_TMO], 1u); break; } }
    }
    nloc = mine > 0u ? mine : 1u; nx = cnt > 0u ? cnt : 1u;
}

__device__ __forceinline__ void xcd_barrier(const XcdBarrier& b) {
    asm volatile("s_waitcnt vmcnt(0)" ::: "memory");
    __syncthreads();
    if (threadIdx.x == 0) {
        unsigned* bar = b.bar;
        __builtin_amdgcn_s_waitcnt(0);
        unsigned nloc = b.st[0], nx = b.st[1];
        if (nloc == 0u) { xcd_barrier_complete(bar, b.x, nloc, nx); b.st[0] = nloc; b.st[1] = nx; }
        const unsigned old = xb_add(&bar[XB_XSUB(b.x)], 1u);
        const unsigned gen = old / nloc;
        if (old + 1u == (gen + 1u) * nloc) {
            __builtin_amdgcn_fence(__ATOMIC_RELEASE, "agent");
            asm volatile("s_waitcnt vmcnt(0)" ::: "memory");
            const unsigned og = xb_add(&bar[XB_TOP], 1u);
            const unsigned tg = og / nx;
            if (og + 1u == (tg + 1u) * nx) xb_add(&bar[XB_TOPGEN], 1u);
            else XB_SPIN(xb_ld(&bar[XB_TOPGEN]) == tg, bar);
            __builtin_amdgcn_fence(__ATOMIC_ACQUIRE, "agent");
            xb_add(&bar[XB_XGEN(b.x)], 1u);
            asm volatile("s_waitcnt vmcnt(0)" ::: "memory");
        } else {
            XB_SPIN(xb_ld(&bar[XB_XGEN(b.x)]) == gen, bar);
            __builtin_amdgcn_fence(__ATOMIC_ACQUIRE, "agent");
            asm volatile("s_waitcnt vmcnt(0)" ::: "memory");
        }
    }
    __syncthreads();
}
constexpr int NWAVES = 8;
constexpr int RING_OFF = 0, RING_BYTES = 159744;
constexpr int LDSCTL_OFF = RING_BYTES, MISC_OFF = LDSCTL_OFF + 320;
constexpr int LDS_BYTES = 163840;
constexpr int CW_TMO = 0, CW_CODE = 1, CW_BAR = 4096;
constexpr int N_BAR_REGIONS = 1;
static_assert((CW_BAR + N_BAR_REGIONS * XCD_BAR_WORDS) * 4 <= (int)CTL_ZERO_BYTES, "ctl");

struct Args { const float* in[25]; float* out; unsigned char* ws; int ph_lo, ph_hi, bar_region, pad; };

struct Frame {
    LAS unsigned char* lds; volatile LAS unsigned* MISC; gu32* ctl;
    int tid, lane, wave, vcu, G;
    unsigned char* ws;
};

constexpr int EPI_SCR_OFF = 132096;
constexpr size_t WS_H15 = 3 * MiB;
namespace pg8 {
typedef unsigned u32x2v __attribute__((ext_vector_type(2)));
struct EpiOut {
    static constexpr bool PERM = false, AFTER_DRAIN = false;
    const float* x; float* out; bf16_t* H1B; float* SSP; PG8_LAS float* P;
    __device__ __forceinline__ void operator()(const f32x4 (&acc)[2][2][4][2], const Unit& u, int wr, int wc, int fr, int fq) const {
        const size_t orow0 = (size_t)u.pm * BM, frow0 = tile_row0(1, u.pm);
        const int col0 = u.pn * BM + wc * 32 + 4 * fq;
#pragma unroll
        for (int ai = 0; ai < 2; ++ai) {
            f32x4 xv[4][2][2];
#pragma unroll
            for (int m = 0; m < 4; ++m)
#pragma unroll
                for (int bj = 0; bj < 2; ++bj)
#pragma unroll
                    for (int n = 0; n < 2; ++n) xv[m][bj][n] = *(const f32x4*)(x + (orow0 + ai * HALF + wr * 64 + m * 16 + fr) * 1024 + col0 + bj * HALF + n * 16);
#pragma unroll
            for (int m = 0; m < 4; ++m) { const int r = ai * HALF + wr * 64 + m * 16 + fr; float ss = 0.f;
#pragma unroll
                for (int bj = 0; bj < 2; ++bj)
#pragma unroll
                    for (int n = 0; n < 2; ++n) { const int c = col0 + bj * HALF + n * 16;
                        const f32x4 h1 = xv[m][bj][n] + acc[ai][bj][m][n];
                        u32x2v w; w.x = cvt_pk_bf16(h1[0], h1[1]); w.y = cvt_pk_bf16(h1[2], h1[3]); *(u32x2v*)(H1B + (frow0 + r) * 1024 + c) = w;
                        ss += (h1[0] * h1[0] + h1[1] * h1[1]) + (h1[2] * h1[2] + h1[3] * h1[3]); }
                ss += __shfl_xor(ss, 16); ss += __shfl_xor(ss, 32);
                if (fq == 0) P[r * 4 + wc] = ss; }
        }
        asm volatile("s_waitcnt lgkmcnt(0)" ::: "memory"); __builtin_amdgcn_s_barrier(); asm volatile("" ::: "memory");
        const int tid = threadIdx.x;
        if (tid < 256) SSP[(size_t)u.pn * 16640 + frow0 + tid] = (P[tid * 4 + 0] + P[tid * 4 + 1]) + (P[tid * 4 + 2] + P[tid * 4 + 3]);
    }
};
struct EpiUpAct {
    static constexpr bool PERM = true, AFTER_DRAIN = false;
    const float* SSP; bf16_t* ACT; bf16_t* GS; bf16_t* US; const float* cw; const float* cb;
    __device__ __forceinline__ void operator()(const f32x4 (&acc)[2][2][4][2], const Unit& u, int wr, int wc, int fr, int fq) const {
        const size_t frow0 = tile_row0(1, u.pm); const int ch0 = u.pn * 128 + wc * 32 + 8 * fq;
#pragma unroll
        for (int ai = 0; ai < 2; ++ai) {
            const size_t rowb = frow0 + ai * HALF + wr * 64; const int tb = u.pm * 4 + ai * 2 + wr;
            float rstd[4];
#pragma unroll
            for (int m = 0; m < 4; ++m) { const size_t row = rowb + m * 16 + fr; const float ss = (SSP[row] + SSP[16640 + row]) + (SSP[2 * 16640 + row] + SSP[3 * 16640 + row]); rstd[m] = 1.0f / sqrtf(ss * (1.0f / 1024.0f) + 1e-6f); }
            f32x4 cw0[2], cw1[2], cw2[2], cbb[2];
#pragma unroll
            for (int n = 0; n < 2; ++n) { const int ch = ch0 + 4 * n; cw0[n] = *(const f32x4*)(cw + ch); cw1[n] = *(const f32x4*)(cw + 2816 + ch); cw2[n] = *(const f32x4*)(cw + 2 * 2816 + ch); cbb[n] = *(const f32x4*)(cb + ch); }
#pragma unroll
            for (int n = 0; n < 2; ++n) {
                const int ch = ch0 + 4 * n;
                const f32x4 w0 = cw0[n], w1 = cw1[n], w2 = cw2[n], bb = cbb[n];
                f32x4 g[4];
#pragma unroll
                for (int m = 0; m < 4; ++m) g[m] = acc[ai][0][m][n] * rstd[m];
#pragma unroll
                for (int m = 0; m < 4; ++m) {
                    const f32x4 gm = g[m], gp_src = g[m > 0 ? m - 1 : 0], gn_src = g[m < 3 ? m + 1 : 3]; f32x4 av;
#pragma unroll
                    for (int e = 0; e < 4; ++e) {
                        const int t_ = __builtin_amdgcn_update_dpp(0, __float_as_int(gp_src[e]), 0x121, 0xf, 0xf, false);
                        const float gprev = __int_as_float(__builtin_amdgcn_update_dpp(t_, __float_as_int(gm[e]), 0x111, 0xf, 0xf, false));
                        const int u_ = __builtin_amdgcn_update_dpp(0, __float_as_int(gn_src[e]), 0x12F, 0xf, 0xf, false);
                        const float gnext = __int_as_float(__builtin_amdgcn_update_dpp(u_, __float_as_int(gm[e]), 0x101, 0xf, 0xf, false));
                        const float gt = w0[e] * gprev + w1[e] * gm[e] + w2[e] * gnext + bb[e];
                        av[e] = gt * __builtin_amdgcn_rcpf(1.f + __builtin_amdgcn_exp2f(-1.4426950408889634f * gt)) * (acc[ai][1][m][n][e] * rstd[m]); }
                    const bool first = (m == 0) && (fr == 0), last = (m == 3) && (fr == 15);
                    if (!(first || last)) { u32x2v w; w.x = cvt_pk_bf16(av[0], av[1]); w.y = cvt_pk_bf16(av[2], av[3]); *(u32x2v*)(ACT + (rowb + m * 16 + fr) * 2816 + ch) = w; }
                    if ((m == 0 && fr < 2) || (m == 3 && fr > 13)) {
                        const int idx = (m == 0) ? fr : fr - 12; u32x2v w; w.x = cvt_pk_bf16(gm[0], gm[1]); w.y = cvt_pk_bf16(gm[2], gm[3]); *(u32x2v*)(GS + ((size_t)tb * 4 + idx) * 2816 + ch) = w; }
                    if (first || last) { const f32x4 uv = acc[ai][1][m][n] * rstd[m]; u32x2v w; w.x = cvt_pk_bf16(uv[0], uv[1]); w.y = cvt_pk_bf16(uv[2], uv[3]); *(u32x2v*)(US + ((size_t)tb * 2 + (last ? 1 : 0)) * 2816 + ch) = w; }
                }
            }
        }
    }
};
struct EpiDown {
    static constexpr bool PERM = false, AFTER_DRAIN = false;
    float* out; const bf16_t* H1B;
    __device__ __forceinline__ void operator()(const f32x4 (&acc)[2][2][4][2], const Unit& u, int wr, int wc, int fr, int fq) const {
        const size_t orow0 = (size_t)u.pm * BM, frow0 = tile_row0(1, u.pm); const int col0 = u.pn * BM + wc * 32 + 4 * fq;
#pragma unroll
        for (int ai = 0; ai < 2; ++ai) {
            u32x2v hv[4][2][2];
#pragma unroll
            for (int m = 0; m < 4; ++m)
#pragma unroll
                for (int bj = 0; bj < 2; ++bj)
#pragma unroll
                    for (int n = 0; n < 2; ++n) hv[m][bj][n] = *(const u32x2v*)(H1B + (frow0 + ai * HALF + wr * 64 + m * 16 + fr) * 1024 + col0 + bj * HALF + n * 16);
#pragma unroll
            for (int m = 0; m < 4; ++m) { float* rp = out + (orow0 + ai * HALF + wr * 64 + m * 16 + fr) * 1024 + col0;
#pragma unroll
                for (int bj = 0; bj < 2; ++bj)
#pragma unroll
                    for (int n = 0; n < 2; ++n) { const u32x2v hw = hv[m][bj][n];
                        const f32x4 h1 = {__uint_as_float(hw.x << 16), __uint_as_float(hw.x & 0xffff0000u), __uint_as_float(hw.y << 16), __uint_as_float(hw.y & 0xffff0000u)};
                        *(f32x4*)(rp + bj * HALF + n * 16) = h1 + acc[ai][bj][m][n]; } }
        }
    }
};
}

__device__ __forceinline__ float dot1024_bf16(const bf16* a, const bf16* b, int lane) {
    float s = 0.f;
#pragma unroll
    for (int h = 0; h < 2; ++h) { const v4u av = *(const GAS v4u*)(a + lane * 16 + h * 8), bv = *(const GAS v4u*)(b + lane * 16 + h * 8);
#pragma unroll
        for (int i = 0; i < 4; ++i) { s += __uint_as_float(av[i] << 16) * __uint_as_float(bv[i] << 16); s += __uint_as_float(av[i] & 0xffff0000u) * __uint_as_float(bv[i] & 0xffff0000u); } }
    return wave_sum(s);
}
__device__ __forceinline__ void row15_outproj(Frame& F, const Args& a) {
    const int gw = F.vcu * NWAVES + F.wave, NGW = F.G * NWAVES, lane = F.lane; unsigned char* ws = F.ws; const float* gm = a.in[18];
    for (int o = gw; o < 2 * D; o += NGW) { const int b = o >> 10, col = o & 1023; const size_t row = (size_t)b * T + 15;
        const bf16* yr = (const bf16*)(ws + WS_YN) + row * D + lane * 16; const bf16* wr = (const bf16*)(ws + WS_WOUT) + (size_t)col * D + lane * 16;
        float s = 0.f, ss = 0.f; const bool mla = lane >= 32;
#pragma unroll
        for (int hh = 0; hh < 2; ++hh) { const v4u av = *(const GAS v4u*)(yr + hh * 8), bv = *(const GAS v4u*)(wr + hh * 8);
#pragma unroll
            for (int i = 0; i < 4; ++i) { const float y0 = __uint_as_float(av[i] << 16), y1 = __uint_as_float(av[i] & 0xffff0000u); const int kk = lane * 16 + hh * 8 + 2 * i;
                const float g0 = mla ? gm[kk - LW] : 1.f, g1 = mla ? gm[kk - LW + 1] : 1.f;
                ss += y0 * y0 + y1 * y1; s += y0 * g0 * __uint_as_float(bv[i] << 16) + y1 * g1 * __uint_as_float(bv[i] & 0xffff0000u); } }
        float sm = mla ? s : 0.f, sl = mla ? 0.f : s, ssm = mla ? ss : 0.f;
        sm = wave_sum(sm); sl = wave_sum(sl); ssm = wave_sum(ssm);
        const float d = sl + sm * (1.f / sqrtf(ssm * (1.f / LW) + EPS));
        if (lane == 0) ((float*)(ws + WS_H15))[o] = a.in[1][15 * D + col] + d; }
}
__device__ __forceinline__ void row15_gate(Frame& F) {
    const int gw = F.vcu * NWAVES + F.wave, NGW = F.G * NWAVES; unsigned char* ws = F.ws; const float* H15 = (const float*)(ws + WS_H15);
    for (int o = gw; o < 2 * FF; o += NGW) { const int b = o / FF, ch = o % FF; const size_t row = (size_t)b * T + 15;
        const bf16* wrow = (const bf16*)(ws + WS_WUP) + (size_t)((ch >> 7) * 256 + (ch & 127)) * D;
        float s = 0.f, ss = 0.f;
#pragma unroll
        for (int h = 0; h < 2; ++h) { const v4u bv = *(const GAS v4u*)(wrow + F.lane * 16 + h * 8);
#pragma unroll
            for (int i = 0; i < 4; ++i) { const float h0v = H15[b * D + F.lane * 16 + h * 8 + 2 * i], h1v = H15[b * D + F.lane * 16 + h * 8 + 2 * i + 1];
                ss += h0v * h0v + h1v * h1v;
                s += __uint_as_float(f2bf(h0v) << 16) * __uint_as_float(bv[i] << 16) + __uint_as_float(f2bf(h1v) << 16) * __uint_as_float(bv[i] & 0xffff0000u); } }
        s = wave_sum(s); ss = wave_sum(ss);
        if (F.lane == 0) ((bf16*)(ws + WS_G))[row * FF + ch] = (bf16)f2bf(s / sqrtf(ss * (1.f / D) + EPS)); }
}

constexpr size_t WS_GS = 241 * MiB, WS_US = 247 * MiB;
static_assert(WS_GS + (size_t)256 * 4 * FF * 2 <= WS_US && WS_US + (size_t)256 * 2 * FF * 2 <= 256 * MiB, "side buffers");
__device__ __forceinline__ void ffn_fix_rows(Frame& F, const Args& a, int pm) {
    unsigned char* ws = F.ws; const bf16* GS = (const bf16*)(ws + WS_GS); const bf16* US = (const bf16*)(ws + WS_US); bf16* ACT = (bf16*)(ws + WS_U); const bf16* G15 = (const bf16*)(ws + WS_G);
    const float* cw = a.in[22]; const float* cb = a.in[23]; const size_t frow0 = pg8::tile_row0(1, pm); const int b = pm >> 5;
    for (int it = F.tid; it < 8 * (FF / 8); it += NWAVES * 64) {
        const int c = (it % (FF / 8)) * 8, bi = it / (FF / 8), blk = bi >> 1, lastrow = bi & 1, tb = pm * 4 + blk;
        const bf16* gm; const bf16* gp; const bf16* gn; bool pz = false, nz = false;
        if (!lastrow) { gm = GS + ((size_t)tb * 4 + 0) * FF; gn = GS + ((size_t)tb * 4 + 1) * FF;
            gp = (blk > 0 || (pm & 31) > 0) ? GS + ((size_t)(tb - 1) * 4 + 3) * FF : G15 + ((size_t)b * T + 15) * FF; }
        else { gm = GS + ((size_t)tb * 4 + 3) * FF; gp = GS + ((size_t)tb * 4 + 2) * FF; nz = (blk == 3 && (pm & 31) == 31); gn = GS + ((size_t)(nz ? tb : tb + 1) * 4 + 0) * FF; }
        (void)pz;
        const v4u g0 = *(const GAS v4u*)(gp + c), g1 = *(const GAS v4u*)(gm + c), g2r = *(const GAS v4u*)(gn + c), uu = *(const GAS v4u*)(US + ((size_t)tb * 2 + lastrow) * FF + c);
        const v4u z = {0u, 0u, 0u, 0u}; const v4u g2 = nz ? z : g2r;
        const f32x4 wa0 = *(const GAS f32x4*)(cw + c), wa1 = *(const GAS f32x4*)(cw + c + 4), wb0 = *(const GAS f32x4*)(cw + FF + c), wb1 = *(const GAS f32x4*)(cw + FF + c + 4),
                    wc0 = *(const GAS f32x4*)(cw + 2 * FF + c), wc1 = *(const GAS f32x4*)(cw + 2 * FF + c + 4), bb0 = *(const GAS f32x4*)(cb + c), bb1 = *(const GAS f32x4*)(cb + c + 4);
        v4u o;
#pragma unroll
        for (int i = 0; i < 4; ++i) { float r[2];
#pragma unroll
            for (int hh = 0; hh < 2; ++hh) { const int e = 2 * i + hh;
                const float a0 = hh ? __uint_as_float(g0[i] & 0xffff0000u) : __uint_as_float(g0[i] << 16), a1 = hh ? __uint_as_float(g1[i] & 0xffff0000u) : __uint_as_float(g1[i] << 16),
                            a2 = hh ? __uint_as_float(g2[i] & 0xffff0000u) : __uint_as_float(g2[i] << 16), up = hh ? __uint_as_float(uu[i] & 0xffff0000u) : __uint_as_float(uu[i] << 16);
                const float w0 = e < 4 ? wa0[e & 3] : wa1[e & 3], w1 = e < 4 ? wb0[e & 3] : wb1[e & 3], w2 = e < 4 ? wc0[e & 3] : wc1[e & 3], bb = e < 4 ? bb0[e & 3] : bb1[e & 3];
                const float gt = w0 * a0 + w1 * a1 + w2 * a2 + bb;
                r[hh] = gt * frcp(1.f + __builtin_amdgcn_exp2f(-1.4426950408889634f * gt)) * up; }
            o[i] = pk2(r[0], r[1]); }
        *(GAS v4u*)(ACT + (frow0 + blk * 64 + (lastrow ? 63 : 0)) * FF + c) = o;
    }
}
namespace att {
using bf16x8 = __attribute__((ext_vector_type(8))) short;
using s16x4  = __attribute__((ext_vector_type(4))) short;
using f32x16 = __attribute__((ext_vector_type(16))) float;
using u32x4  = __attribute__((ext_vector_type(4))) unsigned;
constexpr int NW = 8, QBLK = 32, KVBLK = 64, NT = TK / KVBLK;
static_assert(NT % 2 == 1 && NT >= 5, "loop structure below assumes an odd tile count");
constexpr float SCALE = 0.10206207261596575f;
constexpr float C2 = SCALE * 1.4426950408889634f;
constexpr int SHM_K = KVBLK * 256, SHM_V = KVBLK * VD * 2;
constexpr int NRING = 4;
constexpr int LDS_K = 0, LDS_V = NRING * SHM_K, LDS_WS = LDS_V + NRING * SHM_V, LDS_STG = LDS_WS + NW * 64 * 4, LDS_ATT_BYTES = LDS_STG + NW * 4096;
static_assert(LDS_ATT_BYTES <= RING_BYTES, "attention lds");
#define KSWZ(row, colB) ((row) * 256 + ((colB) ^ (((row) & 15) << 4)))
#define SBAR() __builtin_amdgcn_sched_barrier(0)
__device__ __forceinline__ int crow(int r, int hi) { return (r & 3) + 8 * (r >> 2) + 4 * hi; }
__device__ __forceinline__ unsigned cvtpk(float lo, float hi) { unsigned r; asm volatile("v_cvt_pk_bf16_f32 %0, %1, %2" : "=v"(r) : "v"(lo), "v"(hi)); return r; }
__device__ __forceinline__ void expHalf(f32x16& p) {
#pragma unroll
  for (int r = 0; r < 16; ++r) p[r] = __builtin_amdgcn_exp2f(p[r]);
}
__device__ __forceinline__ void finishSM(f32x16& p0, f32x16& p1, float& l_reg, bf16x8& pa0, bf16x8& pa1, bf16x8& pa2, bf16x8& pa3) {
  expHalf(p1);
  float ps = 0;
#pragma unroll
  for (int r = 0; r < 16; ++r) ps += p0[r];
#pragma unroll
  for (int r = 0; r < 16; ++r) ps += p1[r];
  l_reg += ps;
#define PK4(P, BASE, OUT) do { unsigned a0 = cvtpk(P[BASE + 0], P[BASE + 1]), a1 = cvtpk(P[BASE + 2], P[BASE + 3]);   \
    unsigned b0 = cvtpk(P[BASE + 4], P[BASE + 5]), b1 = cvtpk(P[BASE + 6], P[BASE + 7]);                              \
    auto r0 = __builtin_amdgcn_permlane32_swap(a0, b0, false, false); auto r1 = __builtin_amdgcn_permlane32_swap(a1, b1, false, false); \
    u32x4 w = {r0[0], r1[0], r0[1], r1[1]}; OUT = __builtin_bit_cast(bf16x8, w); } while (0)
  PK4(p0, 0, pa0); PK4(p0, 8, pa1); PK4(p1, 0, pa2); PK4(p1, 8, pa3);
#undef PK4
}
__device__ __forceinline__ void qkt(f32x16& p0, f32x16& p1, const LAS char* Ks, const bf16x8* qr, int r32, int hi) {
  p0 = f32x16{}; p1 = f32x16{};
#pragma unroll
  for (int d0 = 0; d0 < 6; ++d0) { const int cb = (d0 * 16 + hi * 8) * 2;
    const bf16x8 b0 = *(const LAS bf16x8*)(Ks + KSWZ(r32, cb));
    const bf16x8 b1 = *(const LAS bf16x8*)(Ks + KSWZ(32 + r32, cb));
    p0 = __builtin_amdgcn_mfma_f32_32x32x16_bf16(b0, qr[d0], p0, 0, 0, 0);
    p1 = __builtin_amdgcn_mfma_f32_32x32x16_bf16(b1, qr[d0], p1, 0, 0, 0); }
}
__device__ __forceinline__ int v_st(int k, int c) { const int kk = (k & ~0xC) | ((k & 4) << 1) | ((k & 8) >> 1); return ((kk >> 3) * 2 + (c >> 5)) * 512 + ((kk & 7) * 32 + (c & 31)) * 2; }
__device__ __forceinline__ int v_rd_base(int lane) { return ((lane & 3) << 3) | (((lane >> 2) & 3) << 6) | (((lane >> 4) & 1) << 5) | (((lane >> 5) & 1) << 8); }
constexpr int v_rd_off(int d0, int ks, int half) { return d0 * 512 + ks * 2048 + half * 1024; }
template <int OFF> __device__ __forceinline__ s16x4 tr_read(int vb) { s16x4 r; asm volatile("ds_read_b64_tr_b16 %0, %1 offset:%2" : "=&v"(r) : "v"(vb), "i"(OFF) : "memory"); return r; }
template <int D0> __device__ __forceinline__ void pv_one(f32x16& od, int vb, bf16x8 pa0, bf16x8 pa1, bf16x8 pa2, bf16x8 pa3) {
  const s16x4 l0 = tr_read<v_rd_off(D0, 0, 0)>(vb), h0 = tr_read<v_rd_off(D0, 0, 1)>(vb), l1 = tr_read<v_rd_off(D0, 1, 0)>(vb), h1 = tr_read<v_rd_off(D0, 1, 1)>(vb);
  const s16x4 l2 = tr_read<v_rd_off(D0, 2, 0)>(vb), h2 = tr_read<v_rd_off(D0, 2, 1)>(vb), l3 = tr_read<v_rd_off(D0, 3, 0)>(vb), h3 = tr_read<v_rd_off(D0, 3, 1)>(vb);
  asm volatile("s_waitcnt lgkmcnt(0)" ::: "memory"); SBAR();
#define PK(L, H) (bf16x8){L[0], L[1], L[2], L[3], H[0], H[1], H[2], H[3]}
  od = __builtin_amdgcn_mfma_f32_32x32x16_bf16(pa0, PK(l0, h0), od, 0, 0, 0);
  od = __builtin_amdgcn_mfma_f32_32x32x16_bf16(pa1, PK(l1, h1), od, 0, 0, 0);
  od = __builtin_amdgcn_mfma_f32_32x32x16_bf16(pa2, PK(l2, h2), od, 0, 0, 0);
  od = __builtin_amdgcn_mfma_f32_32x32x16_bf16(pa3, PK(l3, h3), od, 0, 0, 0);
#undef PK
}
__device__ __forceinline__ void pv_d0(f32x16* o, int vb, bf16x8 pa0, bf16x8 pa1, bf16x8 pa2, bf16x8 pa3) { pv_one<0>(o[0], vb, pa0, pa1, pa2, pa3); pv_one<1>(o[1], vb, pa0, pa1, pa2, pa3); }

typedef short v4i16_t __attribute__((ext_vector_type(4)));
__device__ __forceinline__ s16x4 vtr(const LAS char* p) { return __builtin_bit_cast(s16x4, __builtin_amdgcn_ds_read_tr16_b64_v4i16((LAS v4i16_t*)p)); }
__device__ __forceinline__ void attn_unit(const bf16* __restrict__ Qb, const bf16* __restrict__ Kh, const bf16* __restrict__ Vh, bf16* __restrict__ Ob, LAS char* lds) {
  const int tid = threadIdx.x, lane = tid & 63, r32 = lane & 31, hi = lane >> 5; const int wid = __builtin_amdgcn_readfirstlane(tid >> 6); const int grp = wid >> 2;
  LAS char* V_lds = lds + LDS_V; LAS char* K_lds = lds + LDS_K;
  LAS float* wsf = (LAS float*)(lds + LDS_WS) + wid * 64; LAS float* li_l = wsf;
  float l_reg = 0; f32x16 o[2] = {}; bf16x8 qr[6];
  const bf16* Qw = Qb + (size_t)(wid * QBLK + r32) * QKD + hi * 8;
#pragma unroll
  for (int d0 = 0; d0 < 6; ++d0) qr[d0] = *(const GAS bf16x8*)(Qw + d0 * 16);
  unsigned ksrc[2], vsrc;
#pragma unroll
  for (int k = 0; k < 2; ++k) { const int pos = (wid * 2 + k) * 64 + lane, row = pos >> 4, piece = (pos & 15) ^ (row & 15); ksrc[k] = (unsigned)(row * QKD + (piece < 12 ? piece : 0) * 8) * 2u; }
  { const int pos = wid * 64 + lane, sub = pos >> 5, within = pos & 31, kk = (sub >> 1) * 8 + (within >> 2), key = (kk & ~0xC) | ((kk & 4) << 1) | ((kk & 8) >> 1), c = (sub & 1) * 32 + (within & 3) * 8;
    vsrc = (unsigned)(key * VD + c) * 2u; }
  const LAS char* vrd = V_lds + v_rd_base(lane);
#define DMA(t) do { const int sl_ = (t) & (NRING - 1); const char* kt_ = (const char*)Kh + (size_t)(t) * (KVBLK * QKD * 2); const char* vt_ = (const char*)Vh + (size_t)(t) * (KVBLK * VD * 2); \
    __builtin_amdgcn_global_load_lds((const GAS unsigned*)(kt_ + ksrc[0]), (LAS unsigned*)(K_lds + sl_ * SHM_K + (wid * 2) * 1024), 16, 0, 0); \
    __builtin_amdgcn_global_load_lds((const GAS unsigned*)(kt_ + ksrc[1]), (LAS unsigned*)(K_lds + sl_ * SHM_K + (wid * 2 + 1) * 1024), 16, 0, 0); \
    __builtin_amdgcn_global_load_lds((const GAS unsigned*)(vt_ + vsrc), (LAS unsigned*)(V_lds + sl_ * SHM_V + wid * 1024), 16, 0, 0); } while (0)
  bf16x8 kf[12]; s16x4 vlo[8], vhi[8];
#define KLOAD(t) do { const LAS char* kb_ = K_lds + ((t) & (NRING - 1)) * SHM_K; _Pragma("unroll") for (int d0 = 0; d0 < 6; ++d0) { const int cb = (d0 * 16 + hi * 8) * 2; \
    kf[2 * d0] = *(const LAS bf16x8*)(kb_ + KSWZ(r32, cb)); kf[2 * d0 + 1] = *(const LAS bf16x8*)(kb_ + KSWZ(32 + r32, cb)); } } while (0)
#define VLOAD(t) do { const LAS char* vb_ = vrd + ((t) & (NRING - 1)) * SHM_V; _Pragma("unroll") for (int d0 = 0; d0 < 2; ++d0) _Pragma("unroll") for (int ks = 0; ks < 4; ++ks) { \
    vlo[d0 * 4 + ks] = vtr(vb_ + v_rd_off(d0, ks, 0)); vhi[d0 * 4 + ks] = vtr(vb_ + v_rd_off(d0, ks, 1)); } } while (0)
#define VFR(i) (bf16x8){vlo[i][0], vlo[i][1], vlo[i][2], vlo[i][3], vhi[i][0], vhi[i][1], vhi[i][2], vhi[i][3]}
#define BAR() do { asm volatile("s_waitcnt vmcnt(0) lgkmcnt(0)" ::: "memory"); __builtin_amdgcn_s_barrier(); asm volatile("" ::: "memory"); } while (0)
  f32x16 p0, p1; bf16x8 pa0, pa1, pa2, pa3;
  DMA(0); DMA(1);
  BAR();
  KLOAD(0);
  if (grp == 1) BAR();
  for (int j = 0; j < NT; ++j) {
    SBAR();
    p0 = f32x16{}; p1 = f32x16{};
#pragma unroll
    for (int d0 = 0; d0 < 6; ++d0) p0 = __builtin_amdgcn_mfma_f32_32x32x16_bf16(kf[2 * d0], qr[d0], p0, 0, 0, 0);
    if (j > 0) {
      o[0] = __builtin_amdgcn_mfma_f32_32x32x16_bf16(pa0, VFR(0), o[0], 0, 0, 0); o[1] = __builtin_amdgcn_mfma_f32_32x32x16_bf16(pa0, VFR(4), o[1], 0, 0, 0);
      o[0] = __builtin_amdgcn_mfma_f32_32x32x16_bf16(pa1, VFR(1), o[0], 0, 0, 0); o[1] = __builtin_amdgcn_mfma_f32_32x32x16_bf16(pa1, VFR(5), o[1], 0, 0, 0);
      o[0] = __builtin_amdgcn_mfma_f32_32x32x16_bf16(pa2, VFR(2), o[0], 0, 0, 0); o[1] = __builtin_amdgcn_mfma_f32_32x32x16_bf16(pa2, VFR(6), o[1], 0, 0, 0);
      o[0] = __builtin_amdgcn_mfma_f32_32x32x16_bf16(pa3, VFR(3), o[0], 0, 0, 0); o[1] = __builtin_amdgcn_mfma_f32_32x32x16_bf16(pa3, VFR(7), o[1], 0, 0, 0);
    }
    SBAR();
    if (j == 0) {
#pragma unroll
      for (int r = 0; r < 16; ++r) p0[r] = -1e30f;
    }
#pragma unroll
    for (int d0 = 0; d0 < 3; ++d0) p1 = __builtin_amdgcn_mfma_f32_32x32x16_bf16(kf[2 * d0 + 1], qr[d0], p1, 0, 0, 0);
    VLOAD(j); if (j + 2 < NT) DMA(j + 2);
    expHalf(p0);
#pragma unroll
    for (int d0 = 3; d0 < 6; ++d0) p1 = __builtin_amdgcn_mfma_f32_32x32x16_bf16(kf[2 * d0 + 1], qr[d0], p1, 0, 0, 0);
    SBAR();
    asm volatile("s_waitcnt lgkmcnt(0)" ::: "memory"); __builtin_amdgcn_s_barrier(); asm volatile("" ::: "memory");
    __builtin_amdgcn_s_setprio(1);
    if (j + 1 < NT) KLOAD(j + 1);
    if (j == 0) {
#pragma unroll
      for (int r = 0; r < 16; ++r) if (crow(r, hi) < JOFF - 32) p1[r] = -1e30f;
    }
    finishSM(p0, p1, l_reg, pa0, pa1, pa2, pa3);
    __builtin_amdgcn_s_setprio(0); SBAR(); BAR();
  }
  SBAR();
  o[0] = __builtin_amdgcn_mfma_f32_32x32x16_bf16(pa0, VFR(0), o[0], 0, 0, 0); o[1] = __builtin_amdgcn_mfma_f32_32x32x16_bf16(pa0, VFR(4), o[1], 0, 0, 0);
  o[0] = __builtin_amdgcn_mfma_f32_32x32x16_bf16(pa1, VFR(1), o[0], 0, 0, 0); o[1] = __builtin_amdgcn_mfma_f32_32x32x16_bf16(pa1, VFR(5), o[1], 0, 0, 0);
  o[0] = __builtin_amdgcn_mfma_f32_32x32x16_bf16(pa2, VFR(2), o[0], 0, 0, 0); o[1] = __builtin_amdgcn_mfma_f32_32x32x16_bf16(pa2, VFR(6), o[1], 0, 0, 0);
  o[0] = __builtin_amdgcn_mfma_f32_32x32x16_bf16(pa3, VFR(3), o[0], 0, 0, 0); o[1] = __builtin_amdgcn_mfma_f32_32x32x16_bf16(pa3, VFR(7), o[1], 0, 0, 0);
  SBAR();
  if (grp == 0) BAR();
#undef DMA
#undef KLOAD
#undef VLOAD
#undef VFR
#undef BAR
  { auto rr = __builtin_amdgcn_permlane32_swap(__float_as_uint(l_reg), __float_as_uint(l_reg), false, false); l_reg = __uint_as_float(rr[0]) + __uint_as_float(rr[1]); }
  if (hi == 0) li_l[r32] = l_reg; asm volatile("s_waitcnt lgkmcnt(0)" ::: "memory");
  float rli[16];
#pragma unroll
  for (int r = 0; r < 16; ++r) rli[r] = __builtin_amdgcn_rcpf(li_l[crow(r, hi)]);
  LAS bf16* stg = (LAS bf16*)(lds + LDS_STG) + wid * 2048;
#pragma unroll
  for (int r = 0; r < 16; ++r) { const int orow = crow(r, hi);
#pragma unroll
    for (int d0 = 0; d0 < 2; ++d0) stg[orow * 64 + d0 * 32 + r32] = (bf16)f2bf(o[d0][r] * rli[r]); }
  asm volatile("s_waitcnt lgkmcnt(0)" ::: "memory");
  bf16* Ow = Ob + (size_t)(wid * QBLK) * 1024;
#pragma unroll
  for (int i = 0; i < 4; ++i) { const int row = i * 8 + (lane >> 3), ch = lane & 7; const u32x4 v = *(const LAS u32x4*)(stg + row * 64 + ch * 8); *(GAS u32x4*)(Ow + (size_t)row * 1024 + ch * 8) = v; }
  __syncthreads();
}
#undef KSWZ
#undef SBAR
}

constexpr size_t WS_PART = 3 * MiB + 64 * 1024;
constexpr int PT = 132;
__device__ __forceinline__ void row15_attn_partials(Frame& F) {
    const int gw = F.vcu * NWAVES + F.wave, NGW = F.G * NWAVES, lane = F.lane; unsigned char* ws = F.ws;
    const bf16* Qh = (const bf16*)(ws + WS_Q); const bf16* Kh = (const bf16*)(ws + WS_K); const bf16* Vh = (const bf16*)(ws + WS_V); float* PART = (float*)(ws + WS_PART);
    for (int wu = gw; wu < NB * NH * att::NT; wu += NGW) {
        const int bh = wu / att::NT, tile = wu % att::NT, j = tile * 64 + lane; const bool valid = j >= JOFF;
        const bf16* qp = Qh + ((size_t)bh * TK + 63) * QKD; const bf16* kp = Kh + ((size_t)bh * TK + j) * QKD;
        float s = 0.f;
#pragma unroll
        for (int c = 0; c < 12; ++c) { const v4u qv = *(const GAS v4u*)(qp + c * 8), kv = *(const GAS v4u*)(kp + c * 8);
#pragma unroll
            for (int i = 0; i < 4; ++i) { s += __uint_as_float(qv[i] << 16) * __uint_as_float(kv[i] << 16); s += __uint_as_float(qv[i] & 0xffff0000u) * __uint_as_float(kv[i] & 0xffff0000u); } }
        s = valid ? s : -1e30f;
        float m = s;
#pragma unroll
        for (int o = 1; o < 64; o <<= 1) m = fmaxf(m, __shfl_xor(m, o));
        const float p = valid ? __builtin_amdgcn_exp2f(s - m) : 0.f; const float l = wave_sum(p);
        float acc = 0.f; const bf16* vp = Vh + ((size_t)bh * TK + tile * 64) * VD + lane;
#pragma unroll 8
        for (int jj = 0; jj < 64; ++jj) acc += __shfl(p, jj) * bf2f(vp[jj * VD]);
        float* pp = PART + (size_t)bh * 66 * PT + tile; pp[(size_t)lane * PT] = acc; if (lane == 0) { pp[64 * PT] = m; pp[65 * PT] = l; }
    }
}
__device__ __forceinline__ void row15_attn_combine(Frame& F, int bh) {
    unsigned char* ws = F.ws; const float* pp = (const float*)(ws + WS_PART) + (size_t)bh * 66 * PT; LAS float* red = (LAS float*)(F.lds + RING_OFF);
    const int w = F.wave, lane = F.lane, b = bh >> 3, h = bh & 7;
    float M = -1e30f;
#pragma unroll
    for (int k = 0; k < 3; ++k) { const int t = lane + 64 * k; M = fmaxf(M, t < att::NT ? pp[64 * PT + t] : -1e30f); }
#pragma unroll
    for (int o = 1; o < 64; o <<= 1) M = fmaxf(M, __shfl_xor(M, o));
    float L = 0.f, O = 0.f;
#pragma unroll
    for (int k = 0; k < 17; ++k) { const int t = w + 8 * k; const bool ok = t < att::NT; const int tc = ok ? t : 0;
        const float f = ok ? __builtin_amdgcn_exp2f(pp[64 * PT + tc] - M) : 0.f; L += f * pp[65 * PT + tc]; O += f * pp[(size_t)lane * PT + tc]; }
    red[w * 65 + lane] = O; if (lane == 0) red[w * 65 + 64] = L;
    __syncthreads();
    if (w == 0) { float Os = 0.f, Ls = 0.f;
#pragma unroll
        for (int i = 0; i < NWAVES; ++i) { Os += red[i * 65 + lane]; Ls += red[i * 65 + 64]; }
        ((bf16*)(ws + WS_YN))[((size_t)b * T + 15) * D + LW + h * VD + lane] = (bf16)f2bf(Os / Ls); }
    __syncthreads();
}
__device__ __forceinline__ void onorm_calc(GAS v4u* p, v4u v, const f32x4 g0, const f32x4 g1) {
    float y[8];
#pragma unroll
    for (int i = 0; i < 4; ++i) { y[2 * i] = __uint_as_float(v[i] << 16); y[2 * i + 1] = __uint_as_float(v[i] & 0xffff0000u); }
    float s = 0.f;
#pragma unroll
    for (int i = 0; i < 8; ++i) s += y[i] * y[i];
    const float rstd = __builtin_amdgcn_rsqf(wave_sum(s) * (1.f / LW) + EPS);
    v4u o; o.x = pk2(y[0] * rstd * g0[0], y[1] * rstd * g0[1]); o.y = pk2(y[2] * rstd * g0[2], y[3] * rstd * g0[3]); o.z = pk2(y[4] * rstd * g1[0], y[5] * rstd * g1[1]); o.w = pk2(y[6] * rstd * g1[2], y[7] * rstd * g1[3]);
    *p = o;
}
__device__ __forceinline__ void onorm_phase(Frame& F, const float* gl, const float* gm) {
    const int gw = F.vcu * NWAVES + F.wave, NGW = F.G * NWAVES, lane = F.lane; bf16* YN = (bf16*)(F.ws + WS_YN);
    const f32x4 gl0 = *(const GAS f32x4*)(gl + lane * 8), gl1 = *(const GAS f32x4*)(gl + lane * 8 + 4), gm0 = *(const GAS f32x4*)(gm + lane * 8), gm1 = *(const GAS f32x4*)(gm + lane * 8 + 4);
    for (int base = gw; base < NB * SEQ; base += 4 * NGW) {
        GAS v4u* p[4]; v4u vl[4], vm[4];
#pragma unroll
        for (int k = 0; k < 4; ++k) { const int orow = base + k * NGW < NB * SEQ ? base + k * NGW : base; const size_t row = (size_t)(orow >> 13) * T + NMETA + (orow & (SEQ - 1));
            p[k] = (GAS v4u*)(YN + row * D + lane * 8); vl[k] = p[k][0]; vm[k] = p[k][64]; }
#pragma unroll
        for (int k = 0; k < 4; ++k) if (base + k * NGW < NB * SEQ) { onorm_calc(p[k], vl[k], gl0, gl1); onorm_calc(p[k] + 64, vm[k], gm0, gm1); }
    }
    if (gw < NB) { GAS v4u* p = (GAS v4u*)(YN + ((size_t)gw * T + 15) * D + lane * 8); onorm_calc(p, *p, gl0, gl1); }
}
__device__ __forceinline__ void attn_phase(Frame& F, const Args& args) {
    unsigned char* ws = F.ws; const bf16* Qh = (const bf16*)(ws + WS_Q); const bf16* Kh = (const bf16*)(ws + WS_K); const bf16* Vh = (const bf16*)(ws + WS_V); bf16* YN = (bf16*)(ws + WS_YN);
    row15_attn_partials(F);
    for (int u = F.vcu; u < NB * NH * (SEQ / 256); u += F.G) {
        const int bh = (u & 255) >> 4, qb = (u & 15) + 16 * (u >> 8), b = bh >> 3, h = bh & 7;
        att::attn_unit(Qh + ((size_t)bh * TK + 64 + 256 * qb) * QKD, Kh + (size_t)bh * TK * QKD, Vh + (size_t)bh * TK * VD,
                       YN + ((size_t)b * T + NMETA + 256 * qb) * D + LW + h * VD, (LAS char*)(F.lds + RING_OFF));
    }
}
namespace mla {
using bf16x8 = __attribute__((ext_vector_type(8))) short;
using f32x16 = __attribute__((ext_vector_type(16))) float;
constexpr int RBLK = (T + 31) / 32;
constexpr int NBLK = NB * RBLK;
constexpr int QWP = 264, KWP = 136;
constexpr int MLA_BASE = 73216;
constexpr int QW_OFF = MLA_BASE, KW_OFF = QW_OFF + QKD * QWP * 2, MLA_LDS = KW_OFF + 128 * KWP * 2;
static_assert(MLA_LDS <= RING_BYTES, "mla lds");
__device__ __forceinline__ int crow(int r, int hi) { return (r & 3) + 8 * (r >> 2) + 4 * hi; }
__device__ __forceinline__ float bflo(unsigned w) { return __uint_as_float(w << 16); }
__device__ __forceinline__ float bfhi(unsigned w) { return __uint_as_float(w & 0xffff0000u); }
__device__ __forceinline__ float xsum(float v) { return v + __shfl_xor(v, 32); }
__device__ __forceinline__ void st4(bf16* p, float a, float b, float c, float d) { u32x2 w; w.x = pk2(a, b); w.y = pk2(c, d); *(GAS u32x2*)p = w; }
__device__ __forceinline__ bf16x8 norm8(bf16x8 x, float rstd, const float* g) {
    const v4u xv = __builtin_bit_cast(v4u, x); const f32x4 g0 = *(const GAS f32x4*)g, g1 = *(const GAS f32x4*)(g + 4);
    v4u o; o.x = pk2(bflo(xv.x) * rstd * g0[0], bfhi(xv.x) * rstd * g0[1]); o.y = pk2(bflo(xv.y) * rstd * g0[2], bfhi(xv.y) * rstd * g0[3]);
    o.z = pk2(bflo(xv.z) * rstd * g1[0], bfhi(xv.z) * rstd * g1[1]); o.w = pk2(bflo(xv.w) * rstd * g1[2], bfhi(xv.w) * rstd * g1[3]);
    return __builtin_bit_cast(bf16x8, o);
}
__device__ __forceinline__ float ss8(bf16x8 x) { const v4u v = __builtin_bit_cast(v4u, x); float s = 0.f;
#pragma unroll
    for (int i = 0; i < 4; ++i) { const float a = bflo(v[i]), b = bfhi(v[i]); s += a * a + b * b; } return s; }

__device__ __forceinline__ void unit(Frame& F, const Args& a, int blk, int h) {
    unsigned char* ws = F.ws; const int lane = F.lane, r32 = lane & 31, hi = lane >> 5;
    const int rb = blk % RBLK, b = blk / RBLK, t = rb * 32 + r32; const bool valid = t < T;
    const bf16* pr = (const bf16*)(ws + WS_PROJ) + ((size_t)b * T + t) * PROJW;
    const LAS bf16* Wq = (const LAS bf16*)(F.lds + RING_OFF + QW_OFF); const LAS bf16* Wk = (const LAS bf16*)(F.lds + RING_OFF + KW_OFF);
    const float* gq = a.in[16]; const float* gk = a.in[17];
    const float2* ropep = (const float2*)(ws + WS_ROPE) + (size_t)(valid ? t : 0) * 16 + 4 * hi;
    {
        bf16x8 bq[16]; float sq = 0.f;
#pragma unroll
        for (int ks = 0; ks < 16; ++ks) { bq[ks] = *(const GAS bf16x8*)(pr + 1024 + ks * 16 + hi * 8); sq += ss8(bq[ks]); }
        const float rq = 1.f / sqrtf(xsum(sq) * (1.f / QL) + EPS);
        {
            bf16* Qo = (bf16*)(ws + WS_Q) + ((size_t)(b * NH + h) * TK + t + JOFF) * QKD;
            f32x16 acc[3] = {};
            const LAS bf16* wp = Wq + (size_t)r32 * QWP + hi * 8;
#pragma unroll
            for (int ks = 0; ks < 16; ++ks)
            { if ((ks & 3) == 0) __builtin_amdgcn_sched_barrier(0);
#pragma unroll
                for (int nb = 0; nb < 3; ++nb) acc[nb] = __builtin_amdgcn_mfma_f32_32x32x16_bf16(*(const LAS bf16x8*)(wp + nb * 32 * QWP + ks * 16), bq[ks], acc[nb], 0, 0, 0); }
            float ss = 0.f;
#pragma unroll
            for (int nb = 0; nb < 3; ++nb)
#pragma unroll
                for (int r = 0; r < 16; ++r) ss += acc[nb][r] * acc[nb][r];
            const float rs = rq / sqrtf(rq * rq * xsum(ss) * (1.f / QKD) + EPS) * (0.10206207261596575f * 1.4426950408889634f);
            if (valid) {
#pragma unroll
                for (int nb = 0; nb < 2; ++nb)
#pragma unroll
                    for (int g4 = 0; g4 < 4; ++g4) { const int d0 = 32 * nb + 8 * g4 + 4 * hi; const f32x4 gg = *(const GAS f32x4*)(gq + d0);
                        st4(Qo + d0, acc[nb][4 * g4] * rs * gg[0], acc[nb][4 * g4 + 1] * rs * gg[1], acc[nb][4 * g4 + 2] * rs * gg[2], acc[nb][4 * g4 + 3] * rs * gg[3]); }
#pragma unroll
                for (int g4 = 0; g4 < 2; ++g4) { const int i0 = 8 * g4 + 4 * hi; const f32x4 ga = *(const GAS f32x4*)(gq + NOPE + i0), gb = *(const GAS f32x4*)(gq + NOPE + 16 + i0);
                    float o1[4], o2[4];
#pragma unroll
                    for (int e = 0; e < 4; ++e) { const float x1 = acc[2][4 * g4 + e] * rs * ga[e], x2 = acc[2][8 + 4 * g4 + e] * rs * gb[e]; const float2 cv = ropep[8 * g4 + e]; const float c = cv.x, s = cv.y;
                        o1[e] = x1 * c - x2 * s; o2[e] = x1 * s + x2 * c; }
                    st4(Qo + NOPE + i0, o1[0], o1[1], o1[2], o1[3]); st4(Qo + NOPE + 16 + i0, o2[0], o2[1], o2[2], o2[3]); }
            }
        }
    }
    {
        bf16x8 bkv[8]; float skv = 0.f;
#pragma unroll
        for (int ks = 0; ks < 8; ++ks) { bkv[ks] = *(const GAS bf16x8*)(pr + 1280 + ks * 16 + hi * 8); skv += ss8(bkv[ks]); }
        const float rkv = 1.f / sqrtf(xsum(skv) * (1.f / KVL) + EPS);
        float kp1[8], kp2[8]; float skp = 0.f;
#pragma unroll
        for (int g4 = 0; g4 < 2; ++g4) { const int i0 = 8 * g4 + 4 * hi;
            const u32x2 w1 = *(const GAS u32x2*)(pr + 1408 + i0), w2 = *(const GAS u32x2*)(pr + 1408 + 16 + i0);
            kp1[4 * g4 + 0] = bflo(w1.x); kp1[4 * g4 + 1] = bfhi(w1.x); kp1[4 * g4 + 2] = bflo(w1.y); kp1[4 * g4 + 3] = bfhi(w1.y);
            kp2[4 * g4 + 0] = bflo(w2.x); kp2[4 * g4 + 1] = bfhi(w2.x); kp2[4 * g4 + 2] = bflo(w2.y); kp2[4 * g4 + 3] = bfhi(w2.y); }
#pragma unroll
        for (int e = 0; e < 8; ++e) skp += kp1[e] * kp1[e] + kp2[e] * kp2[e];
        {
            const size_t orow = ((size_t)(b * NH + h) * TK + t + JOFF);
            bf16* Ko = (bf16*)(ws + WS_K) + orow * QKD; bf16* Vo = (bf16*)(ws + WS_V) + orow * VD;
            f32x16 acc[4] = {};
            const LAS bf16* wp = Wk + (size_t)r32 * KWP + hi * 8;
#pragma unroll
            for (int ks = 0; ks < 8; ++ks)
            { if ((ks & 3) == 0) __builtin_amdgcn_sched_barrier(0);
#pragma unroll
                for (int nb = 0; nb < 4; ++nb) acc[nb] = __builtin_amdgcn_mfma_f32_32x32x16_bf16(*(const LAS bf16x8*)(wp + nb * 32 * KWP + ks * 16), bkv[ks], acc[nb], 0, 0, 0); }
            float ss = 0.f;
#pragma unroll
            for (int nb = 0; nb < 2; ++nb)
#pragma unroll
                for (int r = 0; r < 16; ++r) ss += acc[nb][r] * acc[nb][r];
            const float rs = 1.f / sqrtf(xsum(rkv * rkv * ss + skp) * (1.f / QKD) + EPS), rsn = rs * rkv;
            if (valid) {
#pragma unroll
                for (int nb = 0; nb < 2; ++nb)
#pragma unroll
                    for (int g4 = 0; g4 < 4; ++g4) { const int d0 = 32 * nb + 8 * g4 + 4 * hi; const f32x4 gg = *(const GAS f32x4*)(gk + d0);
                        st4(Ko + d0, acc[nb][4 * g4] * rsn * gg[0], acc[nb][4 * g4 + 1] * rsn * gg[1], acc[nb][4 * g4 + 2] * rsn * gg[2], acc[nb][4 * g4 + 3] * rsn * gg[3]);
                        st4(Vo + d0, acc[2 + nb][4 * g4] * rkv, acc[2 + nb][4 * g4 + 1] * rkv, acc[2 + nb][4 * g4 + 2] * rkv, acc[2 + nb][4 * g4 + 3] * rkv); }
#pragma unroll
                for (int g4 = 0; g4 < 2; ++g4) { const int i0 = 8 * g4 + 4 * hi; const f32x4 ga = *(const GAS f32x4*)(gk + NOPE + i0), gb = *(const GAS f32x4*)(gk + NOPE + 16 + i0);
                    float o1[4], o2[4];
#pragma unroll
                    for (int e = 0; e < 4; ++e) { const float x1 = kp1[4 * g4 + e] * rs * ga[e], x2 = kp2[4 * g4 + e] * rs * gb[e]; const float2 cv = ropep[8 * g4 + e]; const float c = cv.x, s = cv.y;
                        o1[e] = x1 * c - x2 * s; o2[e] = x1 * s + x2 * c; }
                    st4(Ko + NOPE + i0, o1[0], o1[1], o1[2], o1[3]); st4(Ko + NOPE + 16 + i0, o2[0], o2[1], o2[2], o2[3]); }
            }
        }
    }
}
__device__ __forceinline__ void stage(Frame& F, int h) {
    const bf16* sq = (const bf16*)(F.ws + WS_WUQ) + (size_t)h * QKD * QL; const bf16* sk = (const bf16*)(F.ws + WS_WUKV) + (size_t)h * 128 * KVL; LAS unsigned char* dst = F.lds + RING_OFF;
    for (int cid = F.tid; cid < QKD * 32; cid += NWAVES * 64) { const int row = cid >> 5, piece = cid & 31; *(LAS v4u*)(dst + QW_OFF + (size_t)row * (QWP * 2) + piece * 16) = *(const GAS v4u*)(sq + (size_t)cid * 8); }
    for (int cid = F.tid; cid < 128 * 16; cid += NWAVES * 64) { const int row = cid >> 4, piece = cid & 15; *(LAS v4u*)(dst + KW_OFF + (size_t)row * (KWP * 2) + piece * 16) = *(const GAS v4u*)(sk + (size_t)cid * 8); }
}
}
namespace lru {
using bf16x8 = __attribute__((ext_vector_type(8))) short;
constexpr int CL = 80, NSC = CL / 16, NCH = (T + CL - 1) / CL, NUNITS = NB * NH * NCH;
constexpr int XCP = 68;
constexpr int WAVE_LDS = 16 * XCP * 4;
constexpr size_t WS_LSUM = 241 * MiB;
constexpr size_t WS_LSUB = 243 * MiB;
static_assert(NWAVES * WAVE_LDS <= RING_BYTES && WS_LSUM + (size_t)NB * 2 * NCH * 1024 * 4 <= WS_LSUB && WS_LSUB + (size_t)NB * NCH * NSC * 1024 * 4 <= 256 * MiB, "lru maps");

constexpr int WL_OFF = NWAVES * WAVE_LDS, WLP = 72;
constexpr int CST_OFF = WL_OFF + 4 * 64 * WLP * 2;
constexpr int CBL_OFF = CST_OFF + 6 * 64 * 4;
static_assert(CBL_OFF + NWAVES * NSC * 256 <= RING_BYTES, "lru lds");
__device__ __forceinline__ void gate4(const LAS float* XC, const LAS bf16* WLs, const LAS float* CST, const bf16x8 (&af)[2], int dir, int nb, int fr, int fq, int nvalid, float (&av)[4], float (&uv)[4]) {
    f32x4 accA = {0.f, 0.f, 0.f, 0.f}, accX = {0.f, 0.f, 0.f, 0.f};
    const LAS bf16* wl = WLs + (size_t)(dir * 64 + 16 * nb + fr) * WLP + fq * 8;
#pragma unroll
    for (int ks = 0; ks < 2; ++ks) { accA = __builtin_amdgcn_mfma_f32_16x16x32_bf16(af[ks], *(const LAS bf16x8*)(wl + ks * 32), accA, 0, 0, 0);
        accX = __builtin_amdgcn_mfma_f32_16x16x32_bf16(af[ks], *(const LAS bf16x8*)(wl + 2 * 64 * WLP + ks * 32), accX, 0, 0, 0); }
    const int cl = 16 * nb + fr; const float ba = CST[dir * 64 + cl], bx = CST[(2 + dir) * 64 + cl], spv = CST[(4 + dir) * 64 + cl];
#pragma unroll
    for (int r = 0; r < 4; ++r) { const int s = 4 * fq + r;
        const float rg = frcp(1.f + __builtin_amdgcn_exp2f(fmaf(accA[r], -1.4426950408889634f, ba))), ig = frcp(1.f + __builtin_amdgcn_exp2f(fmaf(accX[r], -1.4426950408889634f, bx)));
        float a_ = __builtin_amdgcn_exp2f(rg * spv), u_ = __builtin_amdgcn_sqrtf(fmaxf(fmaf(-a_, a_, 1.f), 0.f)) * ig * XC[s * XCP + 16 * nb + fr];
        if (s >= nvalid) { a_ = 1.f; u_ = 0.f; }
        av[r] = a_; uv[r] = u_; }
}
template <bool FINAL>
__device__ __forceinline__ void unit(Frame& F, const Args& a, int h, int bc) {
    unsigned char* ws = F.ws; const int lane = F.lane, fr = lane & 15, fq = lane >> 4;
    const int ck = bc % NCH, b = bc / NCH, t0 = ck * CL, tend = (t0 + CL < T) ? t0 + CL : T;
    LAS float* XC = (LAS float*)(F.lds + RING_OFF + F.wave * WAVE_LDS); const LAS bf16* WLs = (const LAS bf16*)(F.lds + RING_OFF + WL_OFF);
    const bf16* PROJ = (const bf16*)(ws + WS_PROJ); float* LSUM = (float*)(ws + WS_LSUM); float* LSUB = (float*)(ws + WS_LSUB); bf16* YN = (bf16*)(ws + WS_YN);
    const LAS float* CST = (const LAS float*)(F.lds + RING_OFF + CST_OFF); LAS float* CBL = (LAS float*)(F.lds + RING_OFF + CBL_OFF) + F.wave * (NSC * 64);
    const int cch = 64 * h + lane;
    const bf16* xcol = PROJ + (size_t)b * T * PROJW + cch;
    const float cw0 = a.in[4][cch], cw1 = a.in[4][LW + cch], cw2 = a.in[4][2 * LW + cch], cw3 = a.in[4][3 * LW + cch], cbias = a.in[5][cch];
    float hf[4] = {0.f, 0.f, 0.f, 0.f}, af_[4] = {1.f, 1.f, 1.f, 1.f}, Ab[4] = {1.f, 1.f, 1.f, 1.f}, Hb[4] = {0.f, 0.f, 0.f, 0.f};
    if (FINAL) {
        const float2* smf = (const float2*)LSUM + ((size_t)(b * 2 + 0) * NCH) * 512 + 64 * h + lane; const float2* smb = (const float2*)LSUM + ((size_t)(b * 2 + 1) * NCH) * 512 + 64 * h + lane;
        float xf = 0.f, xb = 0.f;
#pragma unroll 16
        for (int cc = 0; cc < ck; ++cc) { const float2 v = smf[(size_t)cc * 512]; xf = v.x * xf + v.y; }
#pragma unroll 16
        for (int cc = NCH - 1; cc > ck; --cc) { const float2 v = smb[(size_t)cc * 512]; xb = v.x * xb + v.y; }
#pragma unroll
        for (int nb = 0; nb < 4; ++nb) hf[nb] = __shfl(xf, 16 * nb + fr);
        const float* sb = LSUB + ((size_t)(b * NCH + ck) * NSC) * 1024 + 64 * h + lane; float sa[NSC], sh[NSC];
#pragma unroll
        for (int j = 1; j < NSC; ++j) { sa[j] = sb[(size_t)j * 1024]; sh[j] = sb[(size_t)j * 1024 + 512]; }
        CBL[(NSC - 1) * 64 + lane] = xb;
#pragma unroll
        for (int j = NSC - 1; j > 0; --j) { xb = sa[j] * xb + sh[j]; CBL[(j - 1) * 64 + lane] = xb; }
    }
    float xv[19];
#pragma unroll
    for (int i = 0; i < 19; ++i) { const int t = t0 - 2 + i, tc = t < 0 ? 0 : t; const float v = bf2f(xcol[(size_t)tc * PROJW]); xv[i] = (t >= 0 && t < T) ? v : 0.f; }
#pragma unroll 1
    for (int sc = 0; sc < NSC; ++sc) {
        const int ts = t0 + 16 * sc, nvalid = tend - ts;
#pragma unroll
        for (int s = 0; s < 16; ++s) XC[s * XCP + lane] = cbias + cw0 * xv[s] + cw1 * xv[s + 1] + cw2 * xv[s + 2] + cw3 * xv[s + 3];
        if (sc + 1 < NSC) {
            xv[0] = xv[16]; xv[1] = xv[17]; xv[2] = xv[18];
#pragma unroll
            for (int i = 3; i < 19; ++i) { const int t = ts + 14 + i; const float v = bf2f(xcol[(size_t)t * PROJW]); xv[i] = (t < T) ? v : 0.f; }
        }
        unsigned gl[4][2];
        if (FINAL) {
#pragma unroll
            for (int nb = 0; nb < 4; ++nb)
#pragma unroll
                for (int rp = 0; rp < 2; ++rp) { const int s0 = 4 * fq + 2 * rp; const bf16* gp = PROJ + ((size_t)b * T + ts + s0) * PROJW + LW + 64 * h + 16 * nb + fr;
                    const unsigned lo = gp[0], hi = gp[PROJW]; gl[nb][rp] = lo | (hi << 16); }
        }
        asm volatile("s_waitcnt lgkmcnt(0)" ::: "memory");
        bf16x8 af[2];
#pragma unroll
        for (int ks = 0; ks < 2; ++ks) { const LAS f32x4* xp = (const LAS f32x4*)(XC + fr * XCP + 32 * ks + 8 * fq); const f32x4 x0 = xp[0], x1 = xp[1];
            v4u w; w.x = pk2(x0[0], x0[1]); w.y = pk2(x0[2], x0[3]); w.z = pk2(x1[0], x1[1]); w.w = pk2(x1[2], x1[3]); af[ks] = __builtin_bit_cast(bf16x8, w); }
        float hfs[4][4];
#pragma unroll
        for (int nb = 0; nb < 4; ++nb) {
            float av[4], uv[4]; gate4(XC, WLs, CST, af, 0, nb, fr, fq, nvalid, av, uv);
            float A = av[0], H = uv[0];
#pragma unroll
            for (int r = 1; r < 4; ++r) { H = av[r] * H + uv[r]; A *= av[r]; }
            const float A0 = __shfl(A, fr), H0 = __shfl(H, fr), A1 = __shfl(A, fr + 16), H1 = __shfl(H, fr + 16), A2 = __shfl(A, fr + 32), H2 = __shfl(H, fr + 32), A3 = __shfl(A, fr + 48), H3 = __shfl(H, fr + 48);
            const float S0 = hf[nb], S1 = A0 * S0 + H0, S2 = A1 * S1 + H1, S3 = A2 * S2 + H2;
            hf[nb] = A3 * S3 + H3;
            if (FINAL) { float x = fq == 0 ? S0 : fq == 1 ? S1 : fq == 2 ? S2 : S3;
#pragma unroll
                for (int r = 0; r < 4; ++r) { x = av[r] * x + uv[r]; hfs[nb][r] = x; } }
            else af_[nb] *= (A0 * A1) * (A2 * A3);
        }
#pragma unroll
        for (int nb = 0; nb < 4; ++nb) {
            float av[4], uv[4]; gate4(XC, WLs, CST, af, 1, nb, fr, fq, nvalid, av, uv);
            float A = av[3], H = uv[3];
#pragma unroll
            for (int r = 2; r >= 0; --r) { H = av[r] * H + uv[r]; A *= av[r]; }
            const float A0 = __shfl(A, fr), H0 = __shfl(H, fr), A1 = __shfl(A, fr + 16), H1 = __shfl(H, fr + 16), A2 = __shfl(A, fr + 32), H2 = __shfl(H, fr + 32), A3 = __shfl(A, fr + 48), H3 = __shfl(H, fr + 48);
            if (!FINAL) {
                const float al = (A0 * A1) * (A2 * A3), hl = A0 * (A1 * (A2 * H3 + H2) + H1) + H0;
                if (fq == 0) { float* sb = LSUB + ((size_t)(b * NCH + ck) * NSC + sc) * 1024 + 64 * h + 16 * nb + fr; sb[0] = al; sb[512] = hl; }
                Hb[nb] += Ab[nb] * hl; Ab[nb] *= al;
            } else {
                const float S3 = CBL[sc * 64 + 16 * nb + fr];
                const float S2 = A3 * S3 + H3, S1 = A2 * S2 + H2, S0 = A1 * S1 + H1;
                float x = fq == 0 ? S0 : fq == 1 ? S1 : fq == 2 ? S2 : S3;
#pragma unroll
                for (int r = 3; r >= 0; --r) { x = av[r] * x + uv[r];
                    const int s = 4 * fq + r;
                    const float gv = (r & 1) ? __uint_as_float(gl[nb][r >> 1] & 0xffff0000u) : __uint_as_float(gl[nb][r >> 1] << 16);
                    if (s < nvalid) YN[((size_t)b * T + ts + s) * D + 64 * h + 16 * nb + fr] = (bf16)f2bf((hfs[nb][r] + x) * gelu_tanh(gv)); }
            }
        }
    }
    if (!FINAL && fq == 0) {
#pragma unroll
        for (int nb = 0; nb < 4; ++nb) { float2* sm = (float2*)LSUM + ((size_t)(b * 2) * NCH + ck) * 512 + 64 * h + 16 * nb + fr; sm[0] = make_float2(af_[nb], hf[nb]); sm[(size_t)NCH * 512] = make_float2(Ab[nb], Hb[nb]); }
    }
}
__device__ __forceinline__ void stage(Frame& F, const Args& a, int h) {
    const bf16* WL = (const bf16*)(F.ws + WS_WL); LAS unsigned char* dst = F.lds + RING_OFF + WL_OFF;
#pragma unroll
    for (int i = 0; i < 4; ++i) { const int cid = F.tid + 512 * i, m4 = cid >> 9, row = (cid >> 3) & 63, piece = cid & 7;
        *(LAS v4u*)(dst + (size_t)(m4 * 64 + row) * (WLP * 2) + piece * 16) = *(const GAS v4u*)(WL + (size_t)(m4 * 8 + h) * 4096 + row * 64 + piece * 8); }
    if (F.tid < 6 * 64) { const int kind = F.tid >> 7, dir = (F.tid >> 6) & 1, c = F.tid & 63; const float* src = kind == 0 ? a.in[7] : kind == 1 ? a.in[9] : (const float*)(F.ws + WS_SP);
        ((LAS float*)(F.lds + RING_OFF + CST_OFF))[F.tid] = src[dir * LW + 64 * h + c] * (kind == 2 ? -8.f * 1.4426950408889634f : -1.4426950408889634f); }
}
static_assert(CST_OFF + 6 * 64 * 4 <= 73216, "LRU pass-1 region below the MLA weights");
}
__device__ __forceinline__ void p0_tr_item(const float* W, int K, int N, bf16* WT, LAS float* scr, int item, int lane, const float* gk, int upperm) {
    const int nblk = N / 32, kb = item / nblk, nb = item % nblk, k0 = 64 * kb, n0 = 32 * nb;
    float wv[32];
#pragma unroll
    for (int i = 0; i < 32; ++i) wv[i] = W[(size_t)(k0 + 2 * i + (lane >> 5)) * N + n0 + (lane & 31)];
#pragma unroll
    for (int i = 0; i < 32; ++i) { const int kk = 2 * i + (lane >> 5); float w = wv[i]; if (gk) w *= gk[k0 + kk]; scr[kk * 33 + (lane & 31)] = w; }
    LDS_WAIT(); asm volatile("" ::: "memory");
    int orow0 = n0; if (upperm) { const int half = n0 / FF, cidx = n0 % FF; orow0 = (cidx / 128) * 256 + half * 128 + (cidx % 128); }
    const int c = lane & 7;
#pragma unroll
    for (int j = 0; j < 4; ++j) { const int n = (lane >> 3) + 8 * j; const LAS float* s = scr + (8 * c) * 33 + n;
        v4u o; o.x = pk2(s[0 * 33], s[1 * 33]); o.y = pk2(s[2 * 33], s[3 * 33]); o.z = pk2(s[4 * 33], s[5 * 33]); o.w = pk2(s[6 * 33], s[7 * 33]);
        *(GAS v4u*)(WT + (size_t)(orow0 + n) * K + k0 + 8 * c) = o; }
    LDS_WAIT(); asm volatile("" ::: "memory");
}
__device__ __forceinline__ void p0_hn_row(const float* xrow, const float* g, bf16* orow, int lane) {
    const GAS f32x4* xr = (const GAS f32x4*)xrow + lane;
    f32x4 v[4]; float s = 0.f;
#pragma unroll
    for (int j = 0; j < 4; ++j) { v[j] = xr[64 * j]; s += (v[j].x * v[j].x + v[j].y * v[j].y) + (v[j].z * v[j].z + v[j].w * v[j].w); }
    const float rstd = 1.f / sqrtf(wave_sum(s) * (1.f / D) + EPS);
    GAS unsigned long long* o8 = (GAS unsigned long long*)orow + lane;
#pragma unroll
    for (int j = 0; j < 4; ++j) { const f32x4 gg = ((const GAS f32x4*)g)[lane + 64 * j];
        o8[64 * j] = (unsigned long long)pk2(v[j].x * rstd * gg.x, v[j].y * rstd * gg.y) | ((unsigned long long)pk2(v[j].z * rstd * gg.z, v[j].w * rstd * gg.w) << 32); }
}
__device__ __forceinline__ void p0_prologue(Frame& F, const Args& a) {
    LAS float* scr = (LAS float*)(F.lds + RING_OFF + F.wave * 16384);
    const int gw = F.vcu * NWAVES + F.wave, NGW = F.G * NWAVES;
    unsigned char* ws = F.ws;
    constexpr int I_IN = 16 * 45, I_UQ = 4 * 24, I_UKV = 2 * 32, I_L = 64;
    constexpr int NITEMS = I_IN + I_UQ + I_UKV + I_L;
    for (int it = gw; it < NITEMS; it += NGW) {
        int r = it;
        if (r < I_IN) { p0_tr_item(a.in[3], D, INC, (bf16*)(ws + WS_WIN), scr, r, F.lane, nullptr, 0); continue; } r -= I_IN;
        if (r < I_UQ) { p0_tr_item(a.in[13], QL, NH * QKD, (bf16*)(ws + WS_WUQ), scr, r, F.lane, a.in[12], 0); continue; } r -= I_UQ;
        if (r < I_UKV) { p0_tr_item(a.in[15], KVL, NH * 128, (bf16*)(ws + WS_WUKV), scr, r, F.lane, a.in[14], 0); continue; } r -= I_UKV;
        { const int m = r >> 1, gate = m >> 4, dh = m & 15;
          p0_tr_item((gate ? a.in[8] : a.in[6]) + (size_t)dh * 4096, 64, 64, (bf16*)(ws + WS_WL) + (size_t)m * 4096, scr, r & 1, F.lane, nullptr, 0); }
    }
    bf16* HN = (bf16*)(ws + WS_HN);
    for (int m = gw; m < NRP; m += NGW) {
        if (m < NR) p0_hn_row(h0_row(a.in[0], a.in[1], m), a.in[2], HN + (size_t)m * D, F.lane);
        else { GAS unsigned long long* o8 = (GAS unsigned long long*)(HN + (size_t)m * D) + F.lane; for (int j = 0; j < 4; ++j) o8[64 * j] = 0ull; }
    }
    const int gid = F.vcu * (NWAVES * 64) + F.tid, gsz = F.G * NWAVES * 64;
    float2* rope = (float2*)(ws + WS_ROPE);
    for (int i = gid; i < T * 16; i += gsz) {
        const int t = i >> 4, j = i & 15;
        const float inv_freq = rope_inv_freq(j);
        const float ang = (float)t * inv_freq;
        double s, c; sincos_d((double)ang, s, c);
        rope[i] = make_float2((float)c, (float)s);
    }
    float* sp = (float*)(ws + WS_SP);
    for (int i = gid; i < 2 * LW; i += gsz) sp[i] = (float)log1p(exp(-(double)a.in[10][i]));
    { v4u z = {0u, 0u, 0u, 0u}; GAS v4u* wz = (GAS v4u*)(ws + WS_WIN + (size_t)INC * D * 2); for (int i = gid; i < (PROJW - INC) * D * 2 / 16; i += gsz) wz[i] = z; }
    bf16* Q = (bf16*)(ws + WS_Q); bf16* K = (bf16*)(ws + WS_K); bf16* V = (bf16*)(ws + WS_V);
    for (int i = gid; i < NB * NH * JOFF * QKD; i += gsz) { const int bh = i / (JOFF * QKD), r = i % (JOFF * QKD); Q[(size_t)bh * TK * QKD + r] = 0; K[(size_t)bh * TK * QKD + r] = 0; }
    for (int i = gid; i < NB * NH * JOFF * VD; i += gsz) { const int bh = i / (JOFF * VD), r = i % (JOFF * VD); V[(size_t)bh * TK * VD + r] = 0; }
}


constexpr int CW_CONV = 2048;
__device__ __forceinline__ void p2_phase(Frame& F, const Args& a) {
    const int h = F.vcu & 7, cg = F.vcu >> 3, ncg = F.G >> 3;
    lru::stage(F, a, h); mla::stage(F, h);
    if (F.tid == 0) F.MISC[4] = 0u;
    __syncthreads();
    { const int bc = F.wave * ncg + cg; if (bc < NB * lru::NCH) lru::unit<false>(F, a, h, bc); }
    for (;;) { unsigned i = 0; if (F.lane == 0) i = __hip_atomic_fetch_add((LAS unsigned*)&F.MISC[4], 1u, __ATOMIC_RELAXED, __HIP_MEMORY_SCOPE_WORKGROUP);
        i = __builtin_amdgcn_readfirstlane(i); const int blk = cg + ncg * (int)i; if (blk >= mla::NBLK) break; mla::unit(F, a, blk, h); }
    __syncthreads();
}
__device__ __forceinline__ void p3_phase(Frame& F, const Args& a) {
    const int h = F.vcu & 7, cg = F.vcu >> 3, ncg = F.G >> 3;
    lru::stage(F, a, h);
    __syncthreads();
    { const int bc = F.wave * ncg + cg; if (bc < NB * lru::NCH) lru::unit<true>(F, a, h, bc); }
    LAS float* scr = (LAS float*)(F.lds + RING_OFF + 88064 + F.wave * 8448); unsigned char* ws = F.ws;
    constexpr int I_OUT = 16 * 32, I_UP = 16 * 176, I_DN = 44 * 32, NITEMS = I_OUT + I_UP + I_DN;
    { const int slot = F.wave * ncg + cg, nbusy = NB * lru::NCH * 8, nidle = (NWAVES * ncg - NB * lru::NCH) * 8; const bool busy = slot < NB * lru::NCH;
      const int me = busy ? slot * 8 + h : (slot - NB * lru::NCH) * 8 + h, nme = busy ? nbusy : nidle, first = busy ? (6 * nidle < NITEMS ? 6 * nidle : NITEMS) : 0, last = busy ? NITEMS : (6 * nidle < NITEMS ? 6 * nidle : NITEMS);
      for (int it = first + me; it < last; it += nme) { int r = it;
        if (r < I_UP) { p0_tr_item(a.in[21], D, 2 * FF, (bf16*)(ws + WS_WUP), scr, r, F.lane, a.in[20], 1); continue; } r -= I_UP;
        if (r < I_DN) { p0_tr_item(a.in[24], FF, D, (bf16*)(ws + WS_WDN), scr, r, F.lane, nullptr, 0); continue; } r -= I_DN;
        p0_tr_item(a.in[19], D, D, (bf16*)(ws + WS_WOUT), scr, r, F.lane, nullptr, 0); } }
    __syncthreads();
}
__global__ void __launch_bounds__(NWAVES * 64, 2) mega_fwd(Args args) {
    extern __shared__ __attribute__((aligned(16))) unsigned char lds[];
    Frame F;
    F.lds = (LAS unsigned char*)lds; F.MISC = (volatile LAS unsigned*)(F.lds + MISC_OFF);
    F.tid = threadIdx.x; F.lane = F.tid & 63; F.wave = __builtin_amdgcn_readfirstlane(F.tid >> 6);
    F.G = gridDim.x; { const int bx = blockIdx.x; F.vcu = (F.G % 8 == 0) ? (bx % 8) * (F.G / 8) + bx / 8 : bx; }
    F.ws = args.ws; F.ctl = (gu32*)(args.ws + WS_CTL);
    for (int u = F.tid; u < (LDS_BYTES - LDSCTL_OFF) / 4; u += NWAVES * 64) ((LAS unsigned*)(F.lds + LDSCTL_OFF))[u] = 0u;
    __syncthreads();
    XcdBarrier bar = xcd_barrier_post((unsigned*)(F.ctl + CW_BAR) + args.bar_region * XCD_BAR_WORDS, F.MISC + 8);
    const int lo = args.ph_lo, hi = args.ph_hi;
#define IN(k) (lo <= (k) && (k) < hi)
#define BOTH(k) (IN(k) && IN((k) + 1))
#define GRID_BAR() xcd_barrier(bar)
    unsigned char* ws = args.ws;
    if (IN(0)) { p0_prologue(F, args); if (BOTH(0)) GRID_BAR(); }
    if (IN(1)) {
        pg8::Gemm g{(const bf16_t*)(ws + WS_HN), (const bf16_t*)(ws + WS_WIN), NRP, PROJW, D, 0}; pg8::StaticOrder S; S.init(NRP, PROJW, F.G, (int)blockIdx.x);
        pg8::EpiBf16<0> E{(bf16_t*)(ws + WS_PROJ), PROJW, nullptr, 0, 0, 1.f};
        pg8::gemm_phase<pg8::EpiBf16<0>, pg8::StaticOrder, PG8_ALIGN, PG8_SP2>(F.lds + RING_OFF, g, S, E);
        if (BOTH(1)) GRID_BAR();
    }

    if (IN(2)) { p2_phase(F, args); if (BOTH(2)) GRID_BAR(); }
    if (IN(3)) { p3_phase(F, args); }
    if (IN(4)) { attn_phase(F, args); if (BOTH(4)) GRID_BAR(); }
    if (IN(5)) { if (F.vcu < NB * NH) row15_attn_combine(F, F.vcu); onorm_phase(F, args.in[11], args.in[18]); if (BOTH(5)) GRID_BAR(); }
    if (IN(6)) {
        row15_outproj(F, args);
        pg8::Gemm g{(const bf16_t*)(ws + WS_YN), (const bf16_t*)(ws + WS_WOUT), NB * SEQ, D, D, 1}; pg8::StaticOrder S; S.init(NB * SEQ, D, F.G, (int)blockIdx.x);
        pg8::EpiOut E{args.in[0], args.out, (bf16_t*)(ws + WS_H1B), (float*)(ws + WS_SSP), (LAS float*)(F.lds + EPI_SCR_OFF)};
        pg8::gemm_phase<pg8::EpiOut, pg8::StaticOrder, true, PG8_SP2>(F.lds + RING_OFF, g, S, E);
        if (BOTH(6)) GRID_BAR();
    }
    if (IN(7)) {
        row15_gate(F);
        pg8::Gemm g{(const bf16_t*)(ws + WS_H1B), (const bf16_t*)(ws + WS_WUP), NB * SEQ, 2 * FF, D, 1}; pg8::StaticOrder S; S.init(NB * SEQ, 2 * FF, F.G, (int)blockIdx.x);
        pg8::EpiUpAct E{(const float*)(ws + WS_SSP), (bf16_t*)(ws + WS_U), (bf16_t*)(ws + WS_GS), (bf16_t*)(ws + WS_US), args.in[22], args.in[23]};
        pg8::gemm_phase<pg8::EpiUpAct, pg8::StaticOrder, PG8_ALIGN, PG8_SP2>(F.lds + RING_OFF, g, S, E);
        if (BOTH(7) || (IN(7) && IN(9))) GRID_BAR();
    }
    if (IN(9)) {
        pg8::Gemm g{(const bf16_t*)(ws + WS_U), (const bf16_t*)(ws + WS_WDN), NB * SEQ, D, FF, 1}; pg8::StaticOrder S; S.init(NB * SEQ, D, F.G, (int)blockIdx.x);
        { pg8::Unit uu; for (int i = 0; S.next(i, uu); ++i) ffn_fix_rows(F, args, uu.pm); }
        VM_WAIT(); __syncthreads();
        pg8::EpiDown E{args.out, (const bf16_t*)(ws + WS_H1B)};
        pg8::gemm_phase<pg8::EpiDown, pg8::StaticOrder, PG8_ALIGN, PG8_SP2>(F.lds + RING_OFF, g, S, E);
    }
#undef IN
#undef BOTH
}

static int g_grid = 0;
static void launch_mega(const Args& base, int lo, int hi, int region, hipStream_t stream) {
    Args a = base; a.ph_lo = lo; a.ph_hi = hi; a.bar_region = region; a.pad = 0;
    void* params[] = {(void*)&a};
    const hipError_t e = hipLaunchCooperativeKernel((const void*)mega_fwd, dim3(g_grid), dim3(NWAVES * 64), params, LDS_BYTES, stream);
    if (e != hipSuccess) fprintf(stderr, "kernel_launch: cooperative launch [%d,%d) failed: %s (grid %d)\n", lo, hi, hipGetErrorString(e), g_grid);
}
extern "C" void kernel_launch(void* const* d_in, const int* in_sizes, int n_in, void* d_out, int out_size, void* d_ws, size_t ws_size, hipStream_t stream) {
    if (g_grid == 0) {
        if (n_in != 25 || in_sizes[0] != NB * SEQ * D || out_size != NB * SEQ * D || ws_size < 256 * MiB) { fprintf(stderr, "kernel_launch: unexpected shapes n_in %d in0 %d out %d ws %zu\n", n_in, n_in > 0 ? in_sizes[0] : -1, out_size, ws_size); g_grid = -1; return; }
        int dev = 0, cus = 0, per_cu = 0;
        if (hipGetDevice(&dev) != hipSuccess || hipDeviceGetAttribute(&cus, hipDeviceAttributeMultiprocessorCount, dev) != hipSuccess) { g_grid = -1; return; }
        if (hipFuncSetAttribute((const void*)mega_fwd, hipFuncAttributeMaxDynamicSharedMemorySize, LDS_BYTES) != hipSuccess) { fprintf(stderr, "kernel_launch: hipFuncSetAttribute failed\n"); g_grid = -1; return; }
        if (hipOccupancyMaxActiveBlocksPerMultiprocessor(&per_cu, (const void*)mega_fwd, NWAVES * 64, LDS_BYTES) != hipSuccess || per_cu < 1) { fprintf(stderr, "kernel_launch: occupancy query says %d\n", per_cu); per_cu = 1; }
        (void)hipGetLastError();
        g_grid = cus;
    }
    if (g_grid < 0) return;
    unsigned char* ws = (unsigned char*)d_ws; float* out = (float*)d_out;
    if (hipMemsetAsync(ws + WS_CTL, 0, CTL_ZERO_BYTES, stream) != hipSuccess) { fprintf(stderr, "kernel_launch: memset failed\n"); return; }
    Args a{}; for (int i = 0; i < 25; ++i) a.in[i] = (const float*)d_in[i]; a.out = out; a.ws = ws;
    launch_mega(a, 0, 10, 0, stream);
}
```

```cpp
#include <hip/hip_runtime.h>
#include <cstdio>
#include <cstdint>

typedef unsigned short bf16_t;
typedef float f32x4 __attribute__((ext_vector_type(4)));
typedef unsigned u32x4 __attribute__((ext_vector_type(4)));
typedef unsigned u32x2 __attribute__((ext_vector_type(2)));

constexpr int NB = 2, SEQ = 8192, NMETA = 16, T = SEQ + NMETA, D = 1024;
constexpr int NR = NB * T;
constexpr int NRP = 16640;
constexpr int INC = 1440, PROJW = 1536, LW = 512, QL = 256, KVL = 128, RD = 32, NH = 8, QKD = 96, NOPE = 64, VD = 64, FF = 2816;
constexpr int TK = 8256, JOFF = 48;
constexpr float EPS = 1e-6f;

constexpr size_t MiB = 1u << 20;
constexpr size_t WS_CTL = 0, CTL_ZERO_BYTES = 32768;
constexpr size_t WS_ROPE = 1 * MiB;
constexpr size_t WS_SP = WS_ROPE + 1100 * 1024;
constexpr size_t WS_SSP = WS_SP + 8192;
constexpr size_t WS_WIN = 4 * MiB;
constexpr size_t WS_WUQ = 7 * MiB;
constexpr size_t WS_WUKV = 7 * MiB + 512 * 1024;
constexpr size_t WS_WL = 7 * MiB + 768 * 1024;
constexpr size_t WS_WOUT = 8 * MiB;
constexpr size_t WS_WUP = 10 * MiB;
constexpr size_t WS_WDN = 21 * MiB;
constexpr size_t WS_H1B = 27 * MiB;
constexpr size_t WS_G = 60 * MiB;
constexpr size_t WS_U = WS_G + (size_t)NRP * FF * 2;
constexpr size_t WS_END_GU = WS_U + (size_t)NRP * FF * 2;
constexpr size_t WS_HN = 60 * MiB;
constexpr size_t WS_YN = 60 * MiB;
constexpr size_t WS_PROJ = 93 * MiB;
constexpr size_t WS_Q = 142 * MiB;
constexpr size_t WS_K = WS_Q + (size_t)NB * NH * TK * QKD * 2;
constexpr size_t WS_V = WS_K + (size_t)NB * NH * TK * QKD * 2;
constexpr size_t WS_V_END = WS_V + (size_t)NB * NH * TK * VD * 2;
constexpr size_t WS_YL = 208 * MiB;
static_assert(WS_WDN + (size_t)D * FF * 2 <= WS_H1B && WS_H1B + (size_t)NRP * D * 2 <= WS_G, "weights/h1b");
static_assert(WS_HN + (size_t)NRP * D * 2 <= WS_PROJ && WS_PROJ + (size_t)NRP * PROJW * 2 <= WS_Q, "hn/proj");
static_assert(WS_V_END <= 208 * MiB, "qkv");
static_assert(WS_YL + (size_t)NR * LW * 4 <= 256 * MiB, "yl");
static_assert(WS_END_GU <= 240 * MiB, "gu");
static_assert(WS_SSP + 4 * NRP * 4 <= 4 * MiB, "ssp");

__device__ __forceinline__ float bf2f(bf16_t v) { return __uint_as_float((unsigned)v << 16); }
typedef float f32x2_t __attribute__((ext_vector_type(2))); typedef __bf16 bf16x2_t __attribute__((ext_vector_type(2)));
__device__ __forceinline__ unsigned pk2(float lo, float hi) { f32x2_t v = {lo, hi}; bf16x2_t b = __builtin_convertvector(v, bf16x2_t); return __builtin_bit_cast(unsigned, b); }
__device__ __forceinline__ unsigned f2bf(float f) { return pk2(f, 0.f) & 0xffffu; }
__device__ __forceinline__ float fexp(float x) { return __builtin_amdgcn_exp2f(x * 1.4426950408889634f); }
__device__ __forceinline__ float frcp(float x) { return __builtin_amdgcn_rcpf(x); }
__device__ __forceinline__ float wave_sum(float v) {
#pragma unroll
    for (int o = 1; o < 64; o <<= 1) v += __shfl_xor(v, o);
    return v;
}
__device__ __forceinline__ float gelu_tanh(float x) {
    const float u2 = -2.302208198f * (x + 0.044715f * x * x * x);
    return x * __builtin_amdgcn_rcpf(1.f + __builtin_amdgcn_exp2f(u2));
}
__device__ __forceinline__ void sincos_d(double x, double& s, double& c) {
    const double n = rint(x * 0.15915494309189533576888), r = fma(n, -6.283185307179586476925286766559, x), r2 = r * r;
    double cc = -3.76998762881590539e-33, ss = -1.21612504155351811e-34;
    cc = fma(cc, r2, 3.27988923706983776e-30); ss = fma(ss, r2, 1.13099628864477181e-31);
    cc = fma(cc, r2, -2.47959626322479723e-27); ss = fma(ss, r2, -9.18368986379554601e-29);
    cc = fma(cc, r2, 1.61173757109611839e-24); ss = fma(ss, r2, 6.44695028438447359e-26);
    cc = fma(cc, r2, -8.89679139245057408e-22); ss = fma(ss, r2, -3.86817017063068354e-23);
    cc = fma(cc, r2, 4.11031762331216484e-19); ss = fma(ss, r2, 1.95729410633912626e-20);
    cc = fma(cc, r2, -1.56192069685862253e-16); ss = fma(ss, r2, -8.22063524662432950e-18);
    cc = fma(cc, r2, 4.77947733238738525e-14); ss = fma(ss, r2, 2.81145725434552060e-15);
    cc = fma(cc, r2, -1.14707455977297245e-11); ss = fma(ss, r2, -7.64716373181981641e-13);
    cc = fma(cc, r2, 2.08767569878681002e-09); ss = fma(ss, r2, 1.60590438368216133e-10);
    cc = fma(cc, r2, -2.75573192239858883e-07); ss = fma(ss, r2, -2.50521083854417202e-08);
    cc = fma(cc, r2, 2.48015873015873016e-05); ss = fma(ss, r2, 2.75573192239858925e-06);
    cc = fma(cc, r2, -1.38888888888888894e-03); ss = fma(ss, r2, -1.98412698412698413e-04);
    cc = fma(cc, r2, 4.16666666666666644e-02); ss = fma(ss, r2, 8.33333333333333322e-03);
    cc = fma(cc, r2, -5.00000000000000000e-01); ss = fma(ss, r2, -1.66666666666666657e-01);
    c = fma(cc, r2, 1.0); s = r * fma(ss, r2, 1.0);
}
__device__ __forceinline__ float rope_inv_freq(int j) {
    constexpr float T16[16] = {1.000000000e+00f, 5.623413324e-01f, 3.162277639e-01f, 1.778279394e-01f, 1.000000015e-01f, 5.623413250e-02f, 3.162277490e-02f, 1.778279431e-02f, 9.999999776e-03f, 5.623413250e-03f, 3.162277630e-03f, 1.778279431e-03f, 1.000000047e-03f, 5.623413017e-04f, 3.162277571e-04f, 1.778279402e-04f};
    float v = T16[0];
#pragma unroll
    for (int i = 1; i < 16; ++i) v = (j == i) ? T16[i] : v;
    return v;
}
__device__ __forceinline__ const float* h0_row(const float* x, const float* meta, int row) {
    const int b = row / T, t = row % T;
    return t < NMETA ? meta + (size_t)t * D : x + ((size_t)b * SEQ + (t - NMETA)) * D;
}
namespace pg8 {
#define PG8_LAS __attribute__((address_space(3)))
typedef unsigned short bf16_t;
typedef short bf16x8 __attribute__((ext_vector_type(8)));
typedef float f32x4 __attribute__((ext_vector_type(4)));
typedef unsigned u32x4 __attribute__((ext_vector_type(4)));
constexpr int XBUF9 = 139264;
constexpr int BM = 256, BK = 64, HALF = 128, HTB = HALF * BK * 2  , STAGE_BYTES = 8 * HTB, NXCD = 8, WGM = 8;

__host__ __device__ __forceinline__ int lds_byte(int r, int c) { const int st = (r >> 4) * 2 + (c >> 5), rr = r & 15, cc = c & 31, ob = rr * 64 + cc * 2; return st * 1024 + (ob ^ (((ob >> 9) & 1) << 5)); }
__host__ __device__ __forceinline__ void stage_rc(int b, int& R, int& C) { const int st = b / 1024, sb = b % 1024, swz = sb ^ (((sb >> 9) & 1) << 5); R = (st >> 1) * 16 + swz / 64; C = (st & 1) * 32 + (swz % 64) / 2; }
__host__ __device__ __forceinline__ int perm32(int rho) { const int n = rho >> 4, i = rho & 15; return 8 * (i >> 2) + 4 * n + (i & 3); }

struct Unit { int pm, pn, idx; };
struct Gemm { const bf16_t* A; const bf16_t* Bt; int M, N, K; int rowmode; };
__host__ __device__ __forceinline__ size_t tile_row0(int rowmode, int pm) { return rowmode ? (size_t)(pm >> 5) * 8208 + 16 + (size_t)(pm & 31) * 256 : (size_t)pm * 256; }

struct StaticOrder {
    static constexpr bool HALFM = false;
    int nM, nN, nwg, G, c;
    __host__ __device__ void init(int M, int N, int G_, int c_) { nM = M / BM; nN = N / BM; nwg = nM * nN; G = G_; c = c_; }
    __host__ __device__ bool next(int i, Unit& u) const {
        const long L = (long)i * G + c; if (L >= nwg) return false;
        int wgid = (int)L; { const int q = nwg / NXCD, r = nwg % NXCD, xcd = wgid % NXCD, off = wgid / NXCD; wgid = (xcd < r ? xcd * (q + 1) : r * (q + 1) + (xcd - r) * q) + off; }
        const int nig = WGM * nN, gid = wgid / nig, fm = gid * WGM, gsz = (nM - fm) < WGM ? (nM - fm) : WGM;
        u.pm = fm + ((wgid % nig) % gsz); u.pn = (wgid % nig) / gsz; u.idx = i; return true;
    }
    __device__ __forceinline__ void a_ready(const Unit&) const {}
    __device__ __forceinline__ void done(const Unit&) const {}
};

struct StaticOrderLim : StaticOrder {
    int maxr;
    __device__ __forceinline__ bool next(int i, Unit& u) const { return i < maxr && StaticOrder::next(i, u); }
};
struct HalfOrder {
    static constexpr bool HALFM = true;
    int pm, pn, idx, aih;
    __device__ __forceinline__ bool next(int i, Unit& u) const { if (i) return false; u.pm = pm; u.pn = pn; u.idx = idx; return true; }
    __device__ __forceinline__ void a_ready(const Unit&) const {}
    __device__ __forceinline__ void done(const Unit&) const {}
};

__device__ __forceinline__ unsigned cvt_pk_bf16(float lo, float hi) { unsigned r; asm volatile("v_cvt_pk_bf16_f32 %0, %1, %2" : "=v"(r) : "v"(lo), "v"(hi)); return r; }
typedef float f32x2 __attribute__((ext_vector_type(2)));
__device__ __forceinline__ f32x2 gelu_pk(f32x2 v) {
    const f32x2 av = __builtin_elementwise_abs(v), d = av * 0.2316418882f + 1.0f;
    f32x2 t; t.x = __builtin_amdgcn_rcpf(d.x); t.y = __builtin_amdgcn_rcpf(d.y);
    f32x2 q = t * 0.5307027145f + (-0.7265760135f); q = q * t + 0.7107068705f; q = q * t + (-0.142248368f); q = q * t + 0.127414796f; q = q * t;
    const f32x2 s = (v * v) * (-0.72134752044f);
    f32x2 e; e.x = __builtin_amdgcn_exp2f(s.x); e.y = __builtin_amdgcn_exp2f(s.y);
    const f32x2 m = v * (q * e), r = v - m;
    f32x2 o; o.x = v.x < 0.f ? m.x : r.x; o.y = v.y < 0.f ? m.y : r.y; return o;
}

template <int ACT  > struct EpiBf16 {
    static constexpr bool PERM = true, AFTER_DRAIN = false, MIDSCALE = false, APERM = false; static_assert(ACT == 0 || ACT == 1, "EpiBf16: ACT is 0 (none) or 1 (gelu_pk)");
    bf16_t* O; int ldc; const float* bias; int split_cols; size_t split_stride; float scale0;
    __device__ __forceinline__ void operator()(const f32x4 (&acc)[2][2][4][2], const Unit& u, int wr, int wc, int fr, int fq) const {
        const int row0 = u.pm * BM + wr * 64 + fr; int colt = u.pn * BM; bf16_t* base = O;
        float sc = 1.f; if (split_cols) { const int t = colt / split_cols; base += (size_t)t * split_stride; colt -= t * split_cols; if (t == 0) sc = scale0; }
        const int col0 = colt + wc * 32 + 8 * fq, bcol0 = u.pn * BM + wc * 32 + 8 * fq;
        f32x4 bv[2][2];
#pragma unroll
        for (int bj = 0; bj < 2; ++bj)
#pragma unroll
            for (int n = 0; n < 2; ++n) bv[bj][n] = bias ? *(const f32x4*)(bias + bcol0 + bj * HALF + 4 * n) : (f32x4){0.f, 0.f, 0.f, 0.f};
#pragma unroll
        for (int ai = 0; ai < 2; ++ai)
#pragma unroll
            for (int m = 0; m < 4; ++m) { bf16_t* rowp = base + (size_t)(row0 + ai * HALF + m * 16) * ldc + col0;
#pragma unroll
                for (int bj = 0; bj < 2; ++bj) { f32x4 v0 = acc[ai][bj][m][0] + bv[bj][0], v1 = acc[ai][bj][m][1] + bv[bj][1];
                    if (ACT == 1) { f32x2 a = gelu_pk((f32x2){v0[0], v0[1]}), b = gelu_pk((f32x2){v0[2], v0[3]}), c = gelu_pk((f32x2){v1[0], v1[1]}), d = gelu_pk((f32x2){v1[2], v1[3]});
                        v0 = (f32x4){a.x, a.y, b.x, b.y}; v1 = (f32x4){c.x, c.y, d.x, d.y}; }
                    v0 = v0 * sc; v1 = v1 * sc; u32x4 w; w.x = cvt_pk_bf16(v0[0], v0[1]); w.y = cvt_pk_bf16(v0[2], v0[3]); w.z = cvt_pk_bf16(v1[0], v1[1]); w.w = cvt_pk_bf16(v1[2], v1[3]);
                    *(u32x4*)(rowp + bj * HALF) = w; } }
    }
};


template <class Epi, class Sched, bool ALIGN_EPI = false, bool SP2 = false>
__device__ __forceinline__ void gemm_phase(PG8_LAS unsigned char* lds, const Gemm g, const Sched& S, const Epi& E) {
    int tid_ = threadIdx.x; asm volatile("" : "+v"(tid_));
    const int tid = tid_, wid = __builtin_amdgcn_readfirstlane(tid >> 6), lane = tid & 63, wr = wid >> 2, wc = wid & 3, fr = lane & 15, fq = lane >> 4;
    const int K = g.K, nt = K / BK;
    unsigned voffA[2], voffB[2];
#pragma unroll
    for (int i = 0; i < 2; ++i) { int R, C; stage_rc(tid * 16 + i * 8192, R, C); const int Rb = Epi::PERM ? ((R & ~31) + perm32(R & 31)) : R;
        const int Ra = Epi::APERM ? ((R & 64) + 4 * (R & 15) + ((R >> 4) & 3)) : R;
        voffA[i] = (unsigned)(Ra * K + C) * 2u; voffB[i] = (unsigned)(Rb * K + C) * 2u; }
    const size_t kstep = (size_t)(BK * 2);
    const size_t hstep = (size_t)HALF * K * 2;
    const size_t tstep = 2 * hstep;
    const unsigned ldsw = (unsigned)wid * 1024u;
    const int aoff = lds_byte(wr * 64 + fr, fq * 8), boff = lds_byte(wc * 32 + fr, fq * 8);
#define PG8_SA(b, h) (((b) * 2 + (h)) * HTB)
#define PG8_SB(b, h) ((4 + (b) * 2 + (h)) * HTB)
#define PG8_STAGE(bufoff, gbase, voff) do { _Pragma("unroll") for (int _i = 0; _i < 2; ++_i) \
        __builtin_amdgcn_global_load_lds((const unsigned*)((const char*)(gbase) + (voff)[_i]), (PG8_LAS unsigned*)(lds + (bufoff) + ldsw + _i * 8192), 16, 0, 0); } while (0)
#define PG8_LDA(dst, b, h) do { _Pragma("unroll") for (int m = 0; m < 4; ++m) _Pragma("unroll") for (int k = 0; k < 2; ++k) dst[m][k] = *(const PG8_LAS bf16x8*)(lds + PG8_SA(b, h) + aoff + m * 2048 + k * 1024); } while (0)
#define PG8_LDB(dst, b, h) do { _Pragma("unroll") for (int n = 0; n < 2; ++n) _Pragma("unroll") for (int k = 0; k < 2; ++k) dst[n][k] = *(const PG8_LAS bf16x8*)(lds + PG8_SB(b, h) + boff + n * 2048 + k * 1024); } while (0)
#define PG8_MMA(ai, bj, At, Bt) do { __builtin_amdgcn_s_setprio(1); _Pragma("unroll") for (int m = 0; m < 4; ++m) _Pragma("unroll") for (int n = 0; n < 2; ++n) _Pragma("unroll") for (int k = 0; k < 2; ++k) \
        acc[ai][bj][m][n] = __builtin_amdgcn_mfma_f32_16x16x32_bf16(Bt[n][k], At[m][k], acc[ai][bj][m][n], 0, 0, 0); __builtin_amdgcn_s_setprio(0); } while (0)
#define PG8_WAIT_V(n) asm volatile("s_waitcnt vmcnt(" #n ")" ::: "memory")
#define PG8_WAIT_L(n) asm volatile("s_waitcnt lgkmcnt(" #n ")" ::: "memory")
#define PG8_BAR __builtin_amdgcn_s_barrier()
#define PG8_SCHED __builtin_amdgcn_sched_barrier(0)
    Unit cur, nxt; int ui = 0;
    if (!S.next(0, cur)) return;
    f32x4 acc[2][2][4][2];
#pragma unroll
    for (int a = 0; a < 2; ++a)
#pragma unroll
        for (int b = 0; b < 2; ++b)
#pragma unroll
            for (int m = 0; m < 4; ++m)
#pragma unroll
                for (int n = 0; n < 2; ++n) acc[a][b][m][n] = (f32x4){0.f, 0.f, 0.f, 0.f};
    bf16x8 At[4][2], B0[2][2], B1[2][2];
    const size_t rstep = (size_t)K * 2;
    const char* cA = (const char*)g.A + tile_row0(g.rowmode, cur.pm) * rstep; const char* cB = (const char*)g.Bt + (size_t)cur.pn * tstep;
    S.a_ready(cur);
    if constexpr (Sched::HALFM) {
        const char* hA = cA + (size_t)S.aih * hstep;
        bf16x8 Au[4][2], Bu0[2][2], Bu1[2][2];
#define PG8_XOFF(i) ((i) < 8 ? (i) * HTB : XBUF9)
#define PG8_STAGE3(s, kt) do { const int _o0 = PG8_XOFF(3 * (s)), _o1 = PG8_XOFF(3 * (s) + 1), _o2 = PG8_XOFF(3 * (s) + 2); \
        PG8_STAGE(_o0, cB + (size_t)(kt) * kstep, voffB); PG8_STAGE(_o1, cB + hstep + (size_t)(kt) * kstep, voffB); PG8_STAGE(_o2, hA + (size_t)(kt) * kstep, voffA); } while (0)
#define PG8_LD3(Af, Bf0, Bf1, s) do { const int _o0 = PG8_XOFF(3 * (s)), _o1 = PG8_XOFF(3 * (s) + 1), _o2 = PG8_XOFF(3 * (s) + 2); \
        _Pragma("unroll") for (int n = 0; n < 2; ++n) _Pragma("unroll") for (int k = 0; k < 2; ++k) { Bf0[n][k] = *(const PG8_LAS bf16x8*)(lds + _o0 + boff + n * 2048 + k * 1024); Bf1[n][k] = *(const PG8_LAS bf16x8*)(lds + _o1 + boff + n * 2048 + k * 1024); } \
        _Pragma("unroll") for (int m = 0; m < 4; ++m) _Pragma("unroll") for (int k = 0; k < 2; ++k) Af[m][k] = *(const PG8_LAS bf16x8*)(lds + _o2 + aoff + m * 2048 + k * 1024); } while (0)
        PG8_STAGE3(0, 0); PG8_STAGE3(1, 1); PG8_STAGE3(2, 2);
        PG8_WAIT_V(12); PG8_BAR;
        PG8_LD3(At, B0, B1, 0);
        int s = 0;
        for (int t = 0; t < nt; t += 2) {
            {
                const int s1 = (s == 2) ? 0 : s + 1;
                if (t + 2 < nt) PG8_WAIT_V(6); else PG8_WAIT_V(0);
                PG8_WAIT_L(0); PG8_BAR; PG8_SCHED;
                if (t + 3 < nt) PG8_STAGE3(s, t + 3);
                PG8_LD3(Au, Bu0, Bu1, s1); PG8_SCHED;
                PG8_MMA(0, 0, At, B0); PG8_MMA(0, 1, At, B1); PG8_SCHED;
                s = s1; }
            {
                const int s1 = (s == 2) ? 0 : s + 1;
                if (t + 2 < nt) { if (t + 3 < nt) PG8_WAIT_V(6); else PG8_WAIT_V(0); }
                PG8_WAIT_L(0); PG8_BAR; PG8_SCHED;
                if (t + 4 < nt) PG8_STAGE3(s, t + 4);
                if (t + 2 < nt) PG8_LD3(At, B0, B1, s1);
                PG8_SCHED;
                PG8_MMA(0, 0, Au, Bu0); PG8_MMA(0, 1, Au, Bu1); PG8_SCHED;
                s = s1; }
        }
#undef PG8_STAGE3
#undef PG8_LD3
#undef PG8_XOFF
        E(acc, cur, wr, wc, fr, fq); S.done(cur);
        PG8_BAR;
        return;
    }
    if constexpr (SP2) {
        PG8_STAGE(PG8_SB(0, 0), cB, voffB); PG8_STAGE(PG8_SB(0, 1), cB + hstep, voffB); PG8_STAGE(PG8_SA(0, 0), cA, voffA); PG8_STAGE(PG8_SA(0, 1), cA + hstep, voffA);
        if (wr == 1) PG8_BAR;
        PG8_WAIT_V(2); PG8_BAR;
        PG8_STAGE(PG8_SB(1, 0), cB + kstep, voffB); PG8_STAGE(PG8_SA(1, 0), cA + kstep, voffA); PG8_STAGE(PG8_SB(1, 1), cB + hstep + kstep, voffB);
        PG8_WAIT_V(6); PG8_BAR;
    } else {
        PG8_STAGE(PG8_SB(0, 0), cB, voffB); PG8_STAGE(PG8_SA(0, 0), cA, voffA); PG8_STAGE(PG8_SB(0, 1), cB + hstep, voffB); PG8_STAGE(PG8_SA(0, 1), cA + hstep, voffA);
        if (wr == 1) PG8_BAR;
        PG8_WAIT_V(4); PG8_BAR;
        PG8_STAGE(PG8_SB(1, 0), cB + kstep, voffB); PG8_STAGE(PG8_SA(1, 0), cA + kstep, voffA); PG8_STAGE(PG8_SB(1, 1), cB + hstep + kstep, voffB);
        PG8_WAIT_V(6); PG8_BAR;
    }
    for (;;) {
        const bool has_next = S.next(ui + 1, nxt);
        const char* nA = has_next ? (const char*)g.A + tile_row0(g.rowmode, nxt.pm) * rstep : cA; const char* nB = has_next ? (const char*)g.Bt + (size_t)nxt.pn * tstep : cB;
        for (int t = 0; t < nt; t += 2) {
            if constexpr (Epi::MIDSCALE) { if (t == nt / 2) E.mid(acc, cur, wr, wc, fr, fq); }
            const bool last = (t == nt - 2);
            const char* a1 = cA + (size_t)(t + 1) * kstep;
            const char* a2 = last ? nA : cA + (size_t)(t + 2) * kstep; const char* b2 = last ? nB : cB + (size_t)(t + 2) * kstep;
            const char* a3 = a2 + kstep; const char* b3 = b2 + kstep;
            if (last && has_next) S.a_ready(nxt);
            if constexpr (SP2) {
            PG8_LDB(B0, 0, 0); PG8_LDB(B1, 0, 1); PG8_SCHED; PG8_LDA(At, 0, 0); PG8_STAGE(PG8_SA(1, 1), a1 + hstep, voffA);
            PG8_WAIT_V(8); PG8_WAIT_L(0); PG8_BAR; PG8_MMA(0, 0, At, B0); PG8_MMA(0, 1, At, B1); PG8_BAR; PG8_SCHED;
            PG8_LDA(At, 0, 1); PG8_STAGE(PG8_SB(0, 0), b2, voffB); PG8_STAGE(PG8_SB(0, 1), b2 + hstep, voffB); PG8_STAGE(PG8_SA(0, 0), a2, voffA);
            PG8_WAIT_V(8); PG8_WAIT_L(0); PG8_BAR; PG8_MMA(1, 0, At, B0); PG8_MMA(1, 1, At, B1); PG8_BAR; PG8_SCHED;
            PG8_LDB(B0, 1, 0); PG8_LDB(B1, 1, 1); PG8_SCHED; PG8_LDA(At, 1, 0); PG8_STAGE(PG8_SA(0, 1), a2 + hstep, voffA);
            PG8_WAIT_V(8); PG8_WAIT_L(0); PG8_BAR; PG8_MMA(0, 0, At, B0); PG8_MMA(0, 1, At, B1); PG8_BAR; PG8_SCHED;
            PG8_LDA(At, 1, 1); PG8_STAGE(PG8_SB(1, 0), b3, voffB); PG8_STAGE(PG8_SB(1, 1), b3 + hstep, voffB); PG8_STAGE(PG8_SA(1, 0), a3, voffA);
            PG8_WAIT_V(8); PG8_WAIT_L(0); PG8_BAR; PG8_MMA(1, 0, At, B0); PG8_MMA(1, 1, At, B1); PG8_BAR; PG8_SCHED;
            } else {
            PG8_LDB(B0, 0, 0); PG8_SCHED; PG8_LDA(At, 0, 0); PG8_STAGE(PG8_SA(1, 1), a1 + hstep, voffA);
            PG8_WAIT_L(8); PG8_BAR; PG8_WAIT_L(0); PG8_MMA(0, 0, At, B0); PG8_BAR; PG8_SCHED;
            PG8_LDB(B1, 0, 1); PG8_STAGE(PG8_SB(0, 0), b2, voffB);
            PG8_BAR; PG8_WAIT_L(0); PG8_MMA(0, 1, At, B1); PG8_BAR;
            PG8_LDA(At, 0, 1); PG8_STAGE(PG8_SA(0, 0), a2, voffA);
            PG8_BAR; PG8_WAIT_L(0); PG8_MMA(1, 0, At, B0); PG8_BAR; PG8_SCHED;
            PG8_STAGE(PG8_SB(0, 1), b2 + hstep, voffB);
            PG8_WAIT_V(6); PG8_BAR; PG8_MMA(1, 1, At, B1); PG8_BAR;
            PG8_LDB(B0, 1, 0); PG8_SCHED; PG8_LDA(At, 1, 0); PG8_STAGE(PG8_SA(0, 1), a2 + hstep, voffA);
            PG8_WAIT_L(8); PG8_BAR; PG8_WAIT_L(0); PG8_MMA(0, 0, At, B0); PG8_BAR; PG8_SCHED;
            PG8_LDB(B1, 1, 1); PG8_STAGE(PG8_SB(1, 0), b3, voffB);
            PG8_BAR; PG8_WAIT_L(0); PG8_MMA(0, 1, At, B1); PG8_BAR;
            PG8_LDA(At, 1, 1); PG8_STAGE(PG8_SA(1, 0), a3, voffA);
            PG8_BAR; PG8_WAIT_L(0); PG8_MMA(1, 0, At, B0); PG8_BAR; PG8_SCHED;
            PG8_STAGE(PG8_SB(1, 1), b3 + hstep, voffB);
            PG8_WAIT_V(6); PG8_BAR; PG8_MMA(1, 1, At, B1); PG8_BAR;
            }
        }
        if constexpr (ALIGN_EPI) { if (wr == 0) PG8_BAR; }
        if constexpr (!Epi::AFTER_DRAIN) { E(acc, cur, wr, wc, fr, fq); S.done(cur); }
        if (!has_next) break;
#pragma unroll
        for (int a = 0; a < 2; ++a)
#pragma unroll
            for (int b = 0; b < 2; ++b)
#pragma unroll
                for (int m = 0; m < 4; ++m)
#pragma unroll
                    for (int n = 0; n < 2; ++n) acc[a][b][m][n] = (f32x4){0.f, 0.f, 0.f, 0.f};
        cur = nxt; cA = nA; cB = nB; ++ui;
        if constexpr (ALIGN_EPI) { if (wr == 1) PG8_BAR; }
    }
    PG8_WAIT_V(0);
    if constexpr (!ALIGN_EPI) { if (wr == 0) PG8_BAR; }
    PG8_BAR;
    if constexpr (Epi::AFTER_DRAIN) { E.fused(acc, cur, wr, wc, fr, fq, lds, wid, lane); S.done(cur); }
#undef PG8_SA
#undef PG8_SB
#undef PG8_STAGE
#undef PG8_LDA
#undef PG8_LDB
#undef PG8_MMA
#undef PG8_WAIT_V
#undef PG8_WAIT_L
#undef PG8_BAR
#undef PG8_SCHED
}
}
#ifndef PG8_SP2
#define PG8_SP2 true
#endif
#ifndef PG8_ALIGN
#define PG8_ALIGN true
#endif
#define GAS __attribute__((address_space(1)))
#define LAS __attribute__((address_space(3)))
typedef unsigned short bf16;
typedef unsigned v4u __attribute__((ext_vector_type(4)));
typedef float f32x4 __attribute__((ext_vector_type(4)));
typedef short bf16x8 __attribute__((ext_vector_type(8)));
typedef GAS unsigned gu32;
typedef GAS unsigned long long gu64;
#define RLX_AGENT __ATOMIC_RELAXED, __HIP_MEMORY_SCOPE_AGENT
#define LDS_WAIT() asm volatile("s_waitcnt lgkmcnt(0)" ::: "memory")
#define VM_WAIT() asm volatile("s_waitcnt vmcnt(0)" ::: "memory")
__device__ __forceinline__ unsigned long long rt() { return __builtin_amdgcn_s_memrealtime(); }

#define XB_TMO      128
#define XB_XCNT(j)  (256  + 64 * (j))
#define XB_XSUB(j)  (1280 + 64 * (j))
#define XB_XGEN(j)  (2304 + 64 * (j))
#define XB_TOP      3328
#define XB_TOPGEN   3392
#define XCD_BAR_WORDS 3456
#define XB_SPIN_CAP (1u << 18)

__device__ __forceinline__ unsigned xb_ld(unsigned* p)              { return __hip_atomic_load(p, __ATOMIC_RELAXED, __HIP_MEMORY_SCOPE_AGENT); }
__device__ __forceinline__ unsigned xb_add(unsigned* p, unsigned v) { return __hip_atomic_fetch_add(p, v, __ATOMIC_RELAXED, __HIP_MEMORY_SCOPE_AGENT); }
__device__ __forceinline__ unsigned xb_xcc_id() { return (unsigned)__builtin_amdgcn_s_getreg((3 << 11) | 20) & 0xFu; }
#define XB_SPIN(cond, bar) do { unsigned _sp = 0; while (cond) { __builtin_amdgcn_s_sleep(1); \
    if ((++_sp & 255u) == 0u) { if (xb_ld(&(bar)[XB_TMO])) break; if (_sp > XB_SPIN_CAP) { atomicAdd(&(bar)[XB_TMO], 1u); break; } } } } while (0)

struct XcdBarrier {
    unsigned* bar; unsigned x;
    volatile LAS unsigned* st;
};

__device__ __forceinline__ XcdBarrier xcd_barrier_post(unsigned* bar, volatile LAS unsigned* st) {
    XcdBarrier b; b.bar = bar; b.x = xb_xcc_id(); b.st = st;
    if (threadIdx.x == 0) (void)xb_add(&bar[XB_XCNT(b.x)], 1u);
    return b;
}
__device__ __forceinline__ void xcd_barrier_complete(unsigned* bar, unsigned x, unsigned& nloc, unsigned& nx) {
    const unsigned G = gridDim.x * gridDim.y * gridDim.z;
    unsigned sum, cnt, mine, sp = 0u;
    for (;;) {
        sum = 0u; cnt = 0u; mine = 0u;
#pragma unroll
        for (unsigned j = 0; j < 16; ++j) { const unsigned c = xb_ld(&bar[XB_XCNT(j)]); sum += c; cnt += (c > 0u) ? 1u : 0u; mine = (j == x) ? c : mine; }
        if (sum == G) break;
        __builtin_amdgcn_s_sleep(1);
        if ((++sp & 255u) == 0u) { if (xb_ld(&bar[XB_TMO])) break; if (sp > XB_SPIN_CAP) { atomicAdd(&bar[XB_TMO], 1u); break; } }
    }
    nloc = mine > 0u ? mine : 1u; nx = cnt > 0u ? cnt : 1u;
}

__device__ __forceinline__ void xcd_barrier(const XcdBarrier& b) {
    asm volatile("s_waitcnt vmcnt(0)" ::: "memory");
    __syncthreads();
    if (threadIdx.x == 0) {
        unsigned* bar = b.bar;
        __builtin_amdgcn_s_waitcnt(0);
        unsigned nloc = b.st[0], nx = b.st[1];
        if (nloc == 0u) { xcd_barrier_complete(bar, b.x, nloc, nx); b.st[0] = nloc; b.st[1] = nx; }
        const unsigned old = xb_add(&bar[XB_XSUB(b.x)], 1u);
        const unsigned gen = old / nloc;
        if (old + 1u == (gen + 1u) * nloc) {
            __builtin_amdgcn_fence(__ATOMIC_RELEASE, "agent");
            asm volatile("s_waitcnt vmcnt(0)" ::: "memory");
            const unsigned og = xb_add(&bar[XB_TOP], 1u);
            const unsigned tg = og / nx;
            if (og + 1u == (tg + 1u) * nx) xb_add(&bar[XB_TOPGEN], 1u);
            else XB_SPIN(xb_ld(&bar[XB_TOPGEN]) == tg, bar);
            __builtin_amdgcn_fence(__ATOMIC_ACQUIRE, "agent");
            xb_add(&bar[XB_XGEN(b.x)], 1u);
            asm volatile("s_waitcnt vmcnt(0)" ::: "memory");
        } else {
            XB_SPIN(xb_ld(&bar[XB_XGEN(b.x)]) == gen, bar);
            __builtin_amdgcn_fence(__ATOMIC_ACQUIRE, "agent");
            asm volatile("s_waitcnt vmcnt(0)" ::: "memory");
        }
    }
    __syncthreads();
}
constexpr int NWAVES = 8;
constexpr int RING_OFF = 0, RING_BYTES = 159744;
constexpr int LDSCTL_OFF = RING_BYTES, MISC_OFF = LDSCTL_OFF + 320;
constexpr int LDS_BYTES = 163840;
constexpr int CW_TMO = 0, CW_CODE = 1, CW_BAR = 4096;
constexpr int N_BAR_REGIONS = 1;
static_assert((CW_BAR + N_BAR_REGIONS * XCD_BAR_WORDS) * 4 <= (int)CTL_ZERO_BYTES, "ctl");

struct Args { const float* in[25]; float* out; unsigned char* ws; int ph_lo, ph_hi, bar_region, pad; };

struct Frame {
    LAS unsigned char* lds; volatile LAS unsigned* MISC; gu32* ctl;
    int tid, lane, wave, vcu, G;
    unsigned char* ws;
};

constexpr int EPI_SCR_OFF = 132096;
constexpr size_t WS_H15 = 3 * MiB;
namespace pg8 {
typedef unsigned u32x2v __attribute__((ext_vector_type(2)));
struct EpiProj {
    static constexpr bool PERM = true, AFTER_DRAIN = false, MIDSCALE = false, APERM = false;
    bf16_t* O; long long ldc; float* LS; PG8_LAS float* P;
    __device__ __forceinline__ void operator()(const f32x4 (&acc)[2][2][4][2], const Unit& u, int wr, int wc, int fr, int fq) const {
        const int row0 = u.pm * BM + wr * 64 + fr, col0 = u.pn * BM + wc * 32 + 8 * fq; const bool st = u.pn >= 4, both = u.pn == 4;
#pragma unroll
        for (int ai = 0; ai < 2; ++ai)
#pragma unroll
            for (int m = 0; m < 4; ++m) { bf16_t* rowp = O + (size_t)(row0 + ai * HALF + m * 16) * ldc + col0; float ss = 0.f;
#pragma unroll
                for (int bj = 0; bj < 2; ++bj) { const f32x4 v0 = acc[ai][bj][m][0], v1 = acc[ai][bj][m][1];
                    u32x4 w; w.x = cvt_pk_bf16(v0[0], v0[1]); w.y = cvt_pk_bf16(v0[2], v0[3]); w.z = cvt_pk_bf16(v1[0], v1[1]); w.w = cvt_pk_bf16(v1[2], v1[3]);
                    *(u32x4*)(rowp + bj * HALF) = w;
                    if (st && (both || bj == 0)) ss += ((v0[0] * v0[0] + v0[1] * v0[1]) + (v0[2] * v0[2] + v0[3] * v0[3])) + ((v1[0] * v1[0] + v1[1] * v1[1]) + (v1[2] * v1[2] + v1[3] * v1[3])); }
                if (st) { ss += __shfl_xor(ss, 16); ss += __shfl_xor(ss, 32); if (fq == 0) P[(ai * HALF + wr * 64 + m * 16 + fr) * 4 + wc] = ss; } }
        if (st) {
            asm volatile("s_waitcnt lgkmcnt(0)" ::: "memory"); __builtin_amdgcn_s_barrier(); asm volatile("" ::: "memory");
            int tid = threadIdx.x; asm volatile("" : "+v"(tid));
            if (tid < 256) LS[(size_t)(u.pn - 4) * 16640 + (size_t)u.pm * BM + tid] = (P[tid * 4 + 0] + P[tid * 4 + 1]) + (P[tid * 4 + 2] + P[tid * 4 + 3]);
        }
    }
};
struct EpiOut {
    static constexpr bool PERM = false, AFTER_DRAIN = false, MIDSCALE = true, APERM = false;
    const float* x; float* out; bf16_t* H1B; float* SSP; PG8_LAS float* P; const float2* RS;
    __device__ __forceinline__ void mid(f32x4 (&acc)[2][2][4][2], const Unit& u, int wr, int wc, int fr, int fq) const {
        const size_t frow0 = tile_row0(1, u.pm);
#pragma unroll
        for (int ai = 0; ai < 2; ++ai)
#pragma unroll
            for (int m = 0; m < 4; ++m) { const float r = RS[frow0 + ai * HALF + wr * 64 + m * 16 + fr].x;
#pragma unroll
                for (int bj = 0; bj < 2; ++bj)
#pragma unroll
                    for (int n = 0; n < 2; ++n) acc[ai][bj][m][n] = acc[ai][bj][m][n] * r; }
    }
    __device__ __forceinline__ void operator()(const f32x4 (&acc)[2][2][4][2], const Unit& u, int wr, int wc, int fr, int fq) const {
        const size_t orow0 = (size_t)u.pm * BM, frow0 = tile_row0(1, u.pm);
        const int col0 = u.pn * BM + wc * 32 + 4 * fq;
#pragma unroll
        for (int ai = 0; ai < 2; ++ai) {
            f32x4 xv[4][2][2];
#pragma unroll
            for (int m = 0; m < 4; ++m)
#pragma unroll
                for (int bj = 0; bj < 2; ++bj)
#pragma unroll
                    for (int n = 0; n < 2; ++n) xv[m][bj][n] = __builtin_nontemporal_load((const f32x4*)(x + (orow0 + ai * HALF + wr * 64 + m * 16 + fr) * 1024 + col0 + bj * HALF + n * 16));
            float rm[4];
#pragma unroll
            for (int m = 0; m < 4; ++m) rm[m] = RS[frow0 + ai * HALF + wr * 64 + m * 16 + fr].y;
#pragma unroll
            for (int m = 0; m < 4; ++m) { const int r = ai * HALF + wr * 64 + m * 16 + fr; float ss = 0.f;
#pragma unroll
                for (int bj = 0; bj < 2; ++bj)
#pragma unroll
                    for (int n = 0; n < 2; ++n) { const int c = col0 + bj * HALF + n * 16;
                        const f32x4 h1 = xv[m][bj][n] + acc[ai][bj][m][n] * rm[m];
                        u32x2v w; w.x = cvt_pk_bf16(h1[0], h1[1]); w.y = cvt_pk_bf16(h1[2], h1[3]); *(u32x2v*)(H1B + (frow0 + r) * 1024 + c) = w;
                        ss += (h1[0] * h1[0] + h1[1] * h1[1]) + (h1[2] * h1[2] + h1[3] * h1[3]); }
                ss += __shfl_xor(ss, 16); ss += __shfl_xor(ss, 32);
                if (fq == 0) P[r * 4 + wc] = ss; }
        }
        asm volatile("s_waitcnt lgkmcnt(0)" ::: "memory"); __builtin_amdgcn_s_barrier(); asm volatile("" ::: "memory");
        int tid = threadIdx.x; asm volatile("" : "+v"(tid));
        if (tid < 256) SSP[(size_t)u.pn * 16640 + frow0 + tid] = (P[tid * 4 + 0] + P[tid * 4 + 1]) + (P[tid * 4 + 2] + P[tid * 4 + 3]);
    }
};
template <bool HM> struct EpiUpActT {
    static constexpr bool PERM = true, AFTER_DRAIN = false, MIDSCALE = false, APERM = true; static constexpr int NAI = HM ? 1 : 2;
    PG8_LAS const float* RL; bf16_t* ACT; bf16_t* GS; bf16_t* US; const float* cw; const float* cb; int aih;
    __device__ __forceinline__ void operator()(const f32x4 (&acc)[2][2][4][2], const Unit& u, int wr, int wc, int fr, int fq) const {
        const size_t frow0 = tile_row0(1, u.pm); const int ch0 = u.pn * 128 + wc * 32 + 8 * fq;
        const int ah = HM ? aih : 0;
        float rstd8[NAI][4]; f32x4 cw0[2], cw1[2], cw2[2], cbb[2];
#pragma unroll
        for (int ai = 0; ai < NAI; ++ai)
#pragma unroll
            for (int m = 0; m < 4; ++m) rstd8[ai][m] = RL[u.idx * 256 + (ai + ah) * HALF + wr * 64 + 4 * fr + m];
#pragma unroll
        for (int n = 0; n < 2; ++n) { const int ch = ch0 + 4 * n; cw0[n] = *(const f32x4*)(cw + ch); cw1[n] = *(const f32x4*)(cw + 2816 + ch); cw2[n] = *(const f32x4*)(cw + 2 * 2816 + ch); cbb[n] = *(const f32x4*)(cb + ch); }
#pragma unroll
        for (int ai = 0; ai < NAI; ++ai) {
            const size_t rowb = frow0 + (ai + ah) * HALF + wr * 64; const int tb = u.pm * 4 + (ai + ah) * 2 + wr;
            f32x4 g[4][2], gprev0[2], gnext3[2];
#pragma unroll
            for (int n = 0; n < 2; ++n) {
#pragma unroll
                for (int m = 0; m < 4; ++m) g[m][n] = acc[ai][0][m][n] * rstd8[ai][m];
#pragma unroll
                for (int e = 0; e < 4; ++e) {
                    gprev0[n][e] = __int_as_float(__builtin_amdgcn_update_dpp(0, __float_as_int(g[3][n][e]), 0x111, 0xf, 0xf, false));
                    gnext3[n][e] = __int_as_float(__builtin_amdgcn_update_dpp(0, __float_as_int(g[0][n][e]), 0x101, 0xf, 0xf, false)); } }
#pragma unroll
            for (int m = 0; m < 4; ++m) {
                u32x4 wa, wg;
#pragma unroll
                for (int n = 0; n < 2; ++n) {
                    const f32x4 w0 = cw0[n], w1 = cw1[n], w2 = cw2[n], bb = cbb[n];
                    const f32x4 gm = g[m][n], gp = m > 0 ? g[m - 1][n] : gprev0[n], gn = m < 3 ? g[m + 1][n] : gnext3[n]; f32x4 av;
#pragma unroll
                    for (int e = 0; e < 4; ++e) {
                        const float gt = w0[e] * gp[e] + w1[e] * gm[e] + w2[e] * gn[e] + bb[e];
                        av[e] = gt * __builtin_amdgcn_rcpf(1.f + __builtin_amdgcn_exp2f(-1.4426950408889634f * gt)) * (acc[ai][1][m][n][e] * rstd8[ai][m]); }
                    wa[2 * n] = cvt_pk_bf16(av[0], av[1]); wa[2 * n + 1] = cvt_pk_bf16(av[2], av[3]);
                    wg[2 * n] = cvt_pk_bf16(gm[0], gm[1]); wg[2 * n + 1] = cvt_pk_bf16(gm[2], gm[3]); }
                const bool first = (m == 0) && (fr == 0), last = (m == 3) && (fr == 15);
                if (!(first || last)) *(u32x4*)(ACT + (rowb + 4 * fr + m) * 2816 + ch0) = wa;
                if ((m < 2 && fr == 0) || (m >= 2 && fr == 15)) *(u32x4*)(GS + ((size_t)tb * 4 + m) * 2816 + ch0) = wg;
                if (first || last) { const f32x4 u0 = acc[ai][1][m][0] * rstd8[ai][m], u1 = acc[ai][1][m][1] * rstd8[ai][m]; u32x4 w; w.x = cvt_pk_bf16(u0[0], u0[1]); w.y = cvt_pk_bf16(u0[2], u0[3]); w.z = cvt_pk_bf16(u1[0], u1[1]); w.w = cvt_pk_bf16(u1[2], u1[3]);
                    *(u32x4*)(US + ((size_t)tb * 2 + (last ? 1 : 0)) * 2816 + ch0) = w; }
            }
        }
    }
};
struct EpiDown {
    static constexpr bool PERM = false, AFTER_DRAIN = false, MIDSCALE = false, APERM = false;
    float* out; const bf16_t* H1B;
    __device__ __forceinline__ void operator()(const f32x4 (&acc)[2][2][4][2], const Unit& u, int wr, int wc, int fr, int fq) const {
        const size_t orow0 = (size_t)u.pm * BM, frow0 = tile_row0(1, u.pm); const int col0 = u.pn * BM + wc * 32 + 4 * fq;
#pragma unroll
        for (int ai = 0; ai < 2; ++ai) {
            u32x2v hv[4][2][2];
#pragma unroll
            for (int m = 0; m < 4; ++m)
#pragma unroll
                for (int bj = 0; bj < 2; ++bj)
#pragma unroll
                    for (int n = 0; n < 2; ++n) hv[m][bj][n] = *(const u32x2v*)(H1B + (frow0 + ai * HALF + wr * 64 + m * 16 + fr) * 1024 + col0 + bj * HALF + n * 16);
#pragma unroll
            for (int m = 0; m < 4; ++m) { float* rp = out + (orow0 + ai * HALF + wr * 64 + m * 16 + fr) * 1024 + col0;
#pragma unroll
                for (int bj = 0; bj < 2; ++bj)
#pragma unroll
                    for (int n = 0; n < 2; ++n) { const u32x2v hw = hv[m][bj][n];
                        const f32x4 h1 = {__uint_as_float(hw.x << 16), __uint_as_float(hw.x & 0xffff0000u), __uint_as_float(hw.y << 16), __uint_as_float(hw.y & 0xffff0000u)};
                        *(f32x4*)(rp + bj * HALF + n * 16) = h1 + acc[ai][bj][m][n]; } }
        }
    }
};
}

__device__ __forceinline__ float dot1024_bf16(const bf16* a, const bf16* b, int lane) {
    float s = 0.f;
#pragma unroll
    for (int h = 0; h < 2; ++h) { const v4u av = *(const GAS v4u*)(a + lane * 16 + h * 8), bv = *(const GAS v4u*)(b + lane * 16 + h * 8);
#pragma unroll
        for (int i = 0; i < 4; ++i) { s += __uint_as_float(av[i] << 16) * __uint_as_float(bv[i] << 16); s += __uint_as_float(av[i] & 0xffff0000u) * __uint_as_float(bv[i] & 0xffff0000u); } }
    return wave_sum(s);
}
__device__ __forceinline__ void row15_outproj(Frame& F, const Args& a) {
    const int gw = F.vcu * NWAVES + F.wave, NGW = F.G * NWAVES, lane = F.lane; unsigned char* ws = F.ws;
    for (int o = gw; o < 2 * D; o += NGW) { const int b = o >> 10, col = o & 1023; const size_t row = (size_t)b * T + 15;
        const bf16* yr = (const bf16*)(ws + WS_YN) + row * D + lane * 16; const bf16* wr = (const bf16*)(ws + WS_WOUT) + (size_t)col * D + lane * 16;
        float s = 0.f, ss = 0.f; const bool mla = lane >= 32;
#pragma unroll
        for (int hh = 0; hh < 2; ++hh) { const v4u av = *(const GAS v4u*)(yr + hh * 8), bv = *(const GAS v4u*)(wr + hh * 8);
#pragma unroll
            for (int i = 0; i < 4; ++i) { const float y0 = __uint_as_float(av[i] << 16), y1 = __uint_as_float(av[i] & 0xffff0000u);
                ss += y0 * y0 + y1 * y1; s += y0 * __uint_as_float(bv[i] << 16) + y1 * __uint_as_float(bv[i] & 0xffff0000u); } }
        float sm = mla ? s : 0.f, sl = mla ? 0.f : s, ssm = mla ? ss : 0.f, ssl = mla ? 0.f : ss;
        sm = wave_sum(sm); sl = wave_sum(sl); ssm = wave_sum(ssm); ssl = wave_sum(ssl);
        const float d = sl * (1.f / sqrtf(ssl * (1.f / LW) + EPS)) + sm * (1.f / sqrtf(ssm * (1.f / LW) + EPS));
        if (lane == 0) ((float*)(ws + WS_H15))[o] = a.in[1][15 * D + col] + d; }
}
__device__ __forceinline__ void row15_gate(Frame& F) {
    const int gw = F.vcu * NWAVES + F.wave, NGW = F.G * NWAVES; unsigned char* ws = F.ws; const float* H15 = (const float*)(ws + WS_H15);
    for (int o = gw; o < 2 * FF; o += NGW) { const int b = o / FF, ch = o % FF; const size_t row = (size_t)b * T + 15;
        const bf16* wrow = (const bf16*)(ws + WS_WUP) + (size_t)((ch >> 7) * 256 + (ch & 127)) * D;
        float s = 0.f, ss = 0.f;
#pragma unroll
        for (int h = 0; h < 2; ++h) { const v4u bv = *(const GAS v4u*)(wrow + F.lane * 16 + h * 8);
#pragma unroll
            for (int i = 0; i < 4; ++i) { const float h0v = H15[b * D + F.lane * 16 + h * 8 + 2 * i], h1v = H15[b * D + F.lane * 16 + h * 8 + 2 * i + 1];
                ss += h0v * h0v + h1v * h1v;
                s += __uint_as_float(f2bf(h0v) << 16) * __uint_as_float(bv[i] << 16) + __uint_as_float(f2bf(h1v) << 16) * __uint_as_float(bv[i] & 0xffff0000u); } }
        s = wave_sum(s); ss = wave_sum(ss);
        if (F.lane == 0) ((bf16*)(ws + WS_G))[row * FF + ch] = (bf16)f2bf(s / sqrtf(ss * (1.f / D) + EPS)); }
}

constexpr size_t WS_GS = 241 * MiB, WS_US = 247 * MiB;
static_assert(WS_GS + (size_t)256 * 4 * FF * 2 <= WS_US && WS_US + (size_t)256 * 2 * FF * 2 <= 256 * MiB, "side buffers");
__device__ __forceinline__ void ffn_fix_rows(Frame& F, const Args& a, int pm) {
    unsigned char* ws = F.ws; const bf16* GS = (const bf16*)(ws + WS_GS); const bf16* US = (const bf16*)(ws + WS_US); bf16* ACT = (bf16*)(ws + WS_U); const bf16* G15 = (const bf16*)(ws + WS_G);
    const float* cw = a.in[22]; const float* cb = a.in[23]; const size_t frow0 = pg8::tile_row0(1, pm); const int b = pm >> 5;
    for (int cgp = F.tid; cgp < FF / 8; cgp += NWAVES * 64) {
        const int c = cgp * 8;
        const f32x4 wa0 = *(const GAS f32x4*)(cw + c), wa1 = *(const GAS f32x4*)(cw + c + 4), wb0 = *(const GAS f32x4*)(cw + FF + c), wb1 = *(const GAS f32x4*)(cw + FF + c + 4),
                    wc0 = *(const GAS f32x4*)(cw + 2 * FF + c), wc1 = *(const GAS f32x4*)(cw + 2 * FF + c + 4), bb0 = *(const GAS f32x4*)(cb + c), bb1 = *(const GAS f32x4*)(cb + c + 4);
        v4u g0[8], g1[8], g2[8], uu[8];
#pragma unroll
        for (int bi = 0; bi < 8; ++bi) { const int blk = bi >> 1, lastrow = bi & 1, tb = pm * 4 + blk;
            const bf16* gm; const bf16* gp; const bf16* gn; bool nz = false;
            if (!lastrow) { gm = GS + ((size_t)tb * 4 + 0) * FF; gn = GS + ((size_t)tb * 4 + 1) * FF;
                gp = (blk > 0 || (pm & 31) > 0) ? GS + ((size_t)(tb - 1) * 4 + 3) * FF : G15 + ((size_t)b * T + 15) * FF; }
            else { gm = GS + ((size_t)tb * 4 + 3) * FF; gp = GS + ((size_t)tb * 4 + 2) * FF; nz = (blk == 3 && (pm & 31) == 31); gn = GS + ((size_t)(nz ? tb : tb + 1) * 4 + 0) * FF; }
            g0[bi] = *(const GAS v4u*)(gp + c); g1[bi] = *(const GAS v4u*)(gm + c); const v4u g2r = *(const GAS v4u*)(gn + c); uu[bi] = *(const GAS v4u*)(US + ((size_t)tb * 2 + lastrow) * FF + c);
            const v4u z = {0u, 0u, 0u, 0u}; g2[bi] = nz ? z : g2r; }
#pragma unroll
        for (int bi = 0; bi < 8; ++bi) { const int blk = bi >> 1, lastrow = bi & 1;
            v4u o;
#pragma unroll
            for (int i = 0; i < 4; ++i) { float r[2];
#pragma unroll
                for (int hh = 0; hh < 2; ++hh) { const int e = 2 * i + hh;
                    const float a0 = hh ? __uint_as_float(g0[bi][i] & 0xffff0000u) : __uint_as_float(g0[bi][i] << 16), a1 = hh ? __uint_as_float(g1[bi][i] & 0xffff0000u) : __uint_as_float(g1[bi][i] << 16),
                                a2 = hh ? __uint_as_float(g2[bi][i] & 0xffff0000u) : __uint_as_float(g2[bi][i] << 16), up = hh ? __uint_as_float(uu[bi][i] & 0xffff0000u) : __uint_as_float(uu[bi][i] << 16);
                    const float w0 = e < 4 ? wa0[e & 3] : wa1[e & 3], w1 = e < 4 ? wb0[e & 3] : wb1[e & 3], w2 = e < 4 ? wc0[e & 3] : wc1[e & 3], bb = e < 4 ? bb0[e & 3] : bb1[e & 3];
                    const float gt = w0 * a0 + w1 * a1 + w2 * a2 + bb;
                    r[hh] = gt * frcp(1.f + __builtin_amdgcn_exp2f(-1.4426950408889634f * gt)) * up; }
                o[i] = pk2(r[0], r[1]); }
            *(GAS v4u*)(ACT + (frow0 + blk * 64 + (lastrow ? 63 : 0)) * FF + c) = o; }
    }
}
namespace att {
using bf16x8 = __attribute__((ext_vector_type(8))) short;
using s16x4  = __attribute__((ext_vector_type(4))) short;
using u32x4  = __attribute__((ext_vector_type(4))) unsigned;
constexpr int NW = 8, QBLK = 32, KVBLK = 64, NT = TK / KVBLK;
static_assert(NT % 4 == 1 && NT >= 9, "the step loop below is unrolled by the ring depth and peels five steps");
constexpr int SHM_K = KVBLK * 256, SHM_V = KVBLK * VD * 2;
constexpr int NRING = 4;
constexpr int LDS_K = 0, LDS_V = NRING * SHM_K, LDS_WS = LDS_V + NRING * SHM_V, LDS_STG = LDS_WS + NW * 64 * 4, LDS_ATT_BYTES = LDS_STG + NW * 4096;
static_assert(LDS_ATT_BYTES <= RING_BYTES, "attention lds");
#define KSWZ(row, colB) ((row) * 256 + ((colB) ^ (((row) & 15) << 4)))
#define SBAR() __builtin_amdgcn_sched_barrier(0)
__device__ __forceinline__ unsigned cvtpk(float lo, float hi) { unsigned r; asm volatile("v_cvt_pk_bf16_f32 %0, %1, %2" : "=v"(r) : "v"(lo), "v"(hi)); return r; }
typedef short v4i16_t __attribute__((ext_vector_type(4)));
__device__ __forceinline__ s16x4 vtr(const LAS char* p) { return __builtin_bit_cast(s16x4, __builtin_amdgcn_ds_read_tr16_b64_v4i16((LAS v4i16_t*)p)); }
__device__ __forceinline__ bf16x8 mk8(s16x4 l, s16x4 h) { return (bf16x8){l[0], l[1], l[2], l[3], h[0], h[1], h[2], h[3]}; }
using f32x4a = __attribute__((ext_vector_type(4))) float;
__device__ __forceinline__ void attn_unit(const bf16* __restrict__ Qb, const bf16* __restrict__ Kh, const bf16* __restrict__ Vh, bf16* __restrict__ Ob, LAS char* lds) {
  const int tid = threadIdx.x, lane = tid & 63, m16 = lane & 15, g = lane >> 4; const int wid = __builtin_amdgcn_readfirstlane(tid >> 6); const int grp = wid >> 2;
  LAS char* V_lds = lds + LDS_V; LAS char* K_lds = lds + LDS_K;
  bf16x8 qf[2][3];
#pragma unroll
  for (int qt = 0; qt < 2; ++qt)
#pragma unroll
    for (int ks = 0; ks < 3; ++ks) qf[qt][ks] = *(const GAS bf16x8*)(Qb + (size_t)(wid * QBLK + 16 * qt + m16) * QKD + 32 * ks + 8 * g);
  f32x4a ot[4][2] = {}; f32x4a lsq[2] = {}; bf16x8 aones;
  { const short v = (m16 == 0) ? (short)0x3F80 : (short)0; aones = (bf16x8){v, v, v, v, v, v, v, v}; }
  unsigned ksrc[2], vsrc;
#pragma unroll
  for (int k = 0; k < 2; ++k) { const int pos = (wid * 2 + k) * 64 + lane, row = pos >> 4, piece = (pos & 15) ^ (row & 15); ksrc[k] = (unsigned)(row * QKD + (piece < 12 ? piece : 0) * 8) * 2u; }
  { const int key = wid * 8 + (lane & 7), cg = lane >> 3; vsrc = (unsigned)(key * VD + cg * 8) * 2u; }
  const LAS char* vrd = V_lds + ((g >> 1) * 1024 + ((lane & 3) >> 1) * 128 + (g & 1) * 64 + ((lane >> 2) & 3) * 16 + (lane & 1) * 8);
  int kad[3];
#pragma unroll
  for (int ks = 0; ks < 3; ++ks) kad[ks] = KSWZ(m16, (32 * ks + 8 * g) * 2);
  const char* ktp = (const char*)Kh; const char* vtp = (const char*)Vh;
#define DMA1(GP, OFF, LP) asm volatile("s_mov_b32 m0, %0\n\ts_nop 0\n\tglobal_load_lds_dwordx4 %1, %2" :: "s"((unsigned)(size_t)(LP)), "v"(OFF), "s"(GP) : "memory", "m0")
#define DMA(SL) do { DMA1(ktp, ksrc[0], K_lds + (SL) * SHM_K + (wid * 2) * 1024); DMA1(ktp, ksrc[1], K_lds + (SL) * SHM_K + (wid * 2 + 1) * 1024); DMA1(vtp, vsrc, V_lds + (SL) * SHM_V + wid * 1024); \
    ktp += KVBLK * QKD * 2; vtp += KVBLK * VD * 2; } while (0)
  bf16x8 kf[4][3]; s16x4 va[4][2], vb[4][2];
#define KLOAD(SL) do { _Pragma("unroll") for (int kt = 0; kt < 4; ++kt) _Pragma("unroll") for (int ks = 0; ks < 3; ++ks) kf[kt][ks] = *(const LAS bf16x8*)(K_lds + (SL) * SHM_K + kt * 4096 + kad[ks]); } while (0)
#define VLOAD(SL) do { _Pragma("unroll") for (int dt = 0; dt < 4; ++dt) _Pragma("unroll") for (int s_ = 0; s_ < 2; ++s_) { \
    va[dt][s_] = vtr(vrd + (SL) * SHM_V + s_ * 4096 + dt * 256); vb[dt][s_] = vtr(vrd + (SL) * SHM_V + s_ * 4096 + 2048 + dt * 256); } } while (0)
#define BAR() do { asm volatile("s_waitcnt vmcnt(0) lgkmcnt(0)" ::: "memory"); __builtin_amdgcn_s_barrier(); asm volatile("" ::: "memory"); } while (0)
#define BAR3() do { asm volatile("s_waitcnt vmcnt(3) lgkmcnt(0)" ::: "memory"); __builtin_amdgcn_s_barrier(); asm volatile("" ::: "memory"); } while (0)
  f32x4a st[4][2]; bf16x8 pb[2][2];
#pragma unroll
  for (int i = 0; i < 2; ++i) { pb[i][0] = bf16x8{}; pb[i][1] = bf16x8{}; }
#pragma unroll
  for (int dt = 0; dt < 4; ++dt) { va[dt][0] = s16x4{}; va[dt][1] = s16x4{}; vb[dt][0] = s16x4{}; vb[dt][1] = s16x4{}; }
  DMA(0); DMA(1); DMA(2);
  BAR();
#pragma unroll
  for (int qt = 0; qt < 2; ++qt)
#pragma unroll
    for (int ks = 0; ks < 3; ++ks) asm volatile("" : "+v"(qf[qt][ks]));
  KLOAD(0);
  if (grp == 1) BAR();
#define PIN(X) asm volatile("" : "+v"(X))
#define QKH(KT0) do { _Pragma("unroll") for (int ks = 0; ks < 3; ++ks) _Pragma("unroll") for (int kt = (KT0); kt < (KT0) + 2; ++kt) _Pragma("unroll") for (int qt = 0; qt < 2; ++qt) \
      st[kt][qt] = __builtin_amdgcn_mfma_f32_16x16x32_bf16(kf[kt][ks], qf[qt][ks], ks == 0 ? f32x4a{0.f, 0.f, 0.f, 0.f} : st[kt][qt], 0, 0, 0); \
    PIN(st[KT0][0]); PIN(st[KT0][1]); PIN(st[(KT0) + 1][0]); PIN(st[(KT0) + 1][1]); } while (0)
#define STEP(SL, MORE_DMA) do { \
    __builtin_amdgcn_s_setprio(1); SBAR(); \
    QKH(0); SBAR(); \
    _Pragma("unroll") for (int s_ = 0; s_ < 2; ++s_) { \
      _Pragma("unroll") for (int dt = 0; dt < 4; ++dt) _Pragma("unroll") for (int qt = 0; qt < 2; ++qt) ot[dt][qt] = __builtin_amdgcn_mfma_f32_16x16x32_bf16(mk8(va[dt][s_], vb[dt][s_]), pb[s_][qt], ot[dt][qt], 0, 0, 0); } \
    VLOAD(SL); \
    lsq[0] = __builtin_amdgcn_mfma_f32_16x16x32_bf16(aones, pb[0][0], lsq[0], 0, 0, 0); lsq[1] = __builtin_amdgcn_mfma_f32_16x16x32_bf16(aones, pb[0][1], lsq[1], 0, 0, 0); \
    lsq[0] = __builtin_amdgcn_mfma_f32_16x16x32_bf16(aones, pb[1][0], lsq[0], 0, 0, 0); lsq[1] = __builtin_amdgcn_mfma_f32_16x16x32_bf16(aones, pb[1][1], lsq[1], 0, 0, 0); \
    _Pragma("unroll") for (int dt = 0; dt < 4; ++dt) { PIN(ot[dt][0]); PIN(ot[dt][1]); } PIN(lsq[0]); PIN(lsq[1]); \
      \
    __builtin_amdgcn_sched_group_barrier(0x008, 4, 0); \
    _Pragma("unroll") for (int g_ = 0; g_ < 8; ++g_) { __builtin_amdgcn_sched_group_barrier(0x100, 2, 0); __builtin_amdgcn_sched_group_barrier(0x008, 2, 0); } \
    SBAR(); \
    if (MORE_DMA) DMA(((SL) + 3) & 3); \
    QKH(2); SBAR(); \
    __builtin_amdgcn_s_barrier(); asm volatile("" ::: "memory");        \
    __builtin_amdgcn_s_setprio(0); \
    KLOAD(((SL) + 1) & 3); \
    _Pragma("unroll") for (int kt = 0; kt < 4; ++kt) _Pragma("unroll") for (int qt = 0; qt < 2; ++qt) _Pragma("unroll") for (int i = 0; i < 4; ++i) st[kt][qt][i] = __builtin_amdgcn_exp2f(st[kt][qt][i]); \
    _Pragma("unroll") for (int s_ = 0; s_ < 2; ++s_) _Pragma("unroll") for (int qt = 0; qt < 2; ++qt) { \
      u32x4 w = {cvtpk(st[2 * s_][qt][0], st[2 * s_][qt][1]), cvtpk(st[2 * s_][qt][2], st[2 * s_][qt][3]), cvtpk(st[2 * s_ + 1][qt][0], st[2 * s_ + 1][qt][1]), cvtpk(st[2 * s_ + 1][qt][2], st[2 * s_ + 1][qt][3])}; \
      pb[s_][qt] = __builtin_bit_cast(bf16x8, w); } \
    SBAR(); if (MORE_DMA) BAR3(); else BAR(); } while (0)
  for (int j0 = 0; j0 < NT - 5; j0 += 4) { STEP(0, true); STEP(1, true); STEP(2, true); STEP(3, true); }
  STEP(0, true); STEP(1, true); STEP(2, false); STEP(3, false); STEP(0, false);
  SBAR();
#pragma unroll
  for (int s_ = 0; s_ < 2; ++s_) {
#pragma unroll
    for (int dt = 0; dt < 4; ++dt)
#pragma unroll
      for (int qt = 0; qt < 2; ++qt) ot[dt][qt] = __builtin_amdgcn_mfma_f32_16x16x32_bf16(mk8(va[dt][s_], vb[dt][s_]), pb[s_][qt], ot[dt][qt], 0, 0, 0);
    lsq[0] = __builtin_amdgcn_mfma_f32_16x16x32_bf16(aones, pb[s_][0], lsq[0], 0, 0, 0); lsq[1] = __builtin_amdgcn_mfma_f32_16x16x32_bf16(aones, pb[s_][1], lsq[1], 0, 0, 0); }
  SBAR();
  if (grp == 0) BAR();
#undef STEP
#undef QKH
#undef PIN
#undef DMA
#undef DMA1
#undef KLOAD
#undef VLOAD
#undef BAR
#undef BAR3
  LAS bf16* stg = (LAS bf16*)(lds + LDS_STG) + wid * 2048;
#pragma unroll
  for (int qt = 0; qt < 2; ++qt) { const float rl = __builtin_amdgcn_rcpf(__shfl(lsq[qt][0], m16) - (float)JOFF);
#pragma unroll
    for (int dt = 0; dt < 4; ++dt) { u32x2 w; w.x = cvtpk(ot[dt][qt][0] * rl, ot[dt][qt][1] * rl); w.y = cvtpk(ot[dt][qt][2] * rl, ot[dt][qt][3] * rl);
      *(LAS u32x2*)(stg + (16 * qt + m16) * 64 + 16 * dt + 4 * g) = w; } }
  asm volatile("s_waitcnt lgkmcnt(0)" ::: "memory");
  bf16* Ow = Ob + (size_t)(wid * QBLK) * 1024;
#pragma unroll
  for (int i = 0; i < 4; ++i) { const int row = i * 8 + (lane >> 3), ch = lane & 7; const u32x4 v = *(const LAS u32x4*)(stg + row * 64 + ch * 8); *(GAS u32x4*)(Ow + (size_t)row * 1024 + ch * 8) = v; }
  __syncthreads();
}
#undef KSWZ
#undef SBAR
}

constexpr size_t WS_PART = 3 * MiB + 64 * 1024;
constexpr int PT = 132;
__device__ __forceinline__ void row15_attn_partials(Frame& F) {
    if (F.wave >= 4 && F.wave != 7) return;
    const int gw = F.vcu * 5 + (F.wave < 4 ? F.wave : 4), NGW = F.G * 5, lane = F.lane, l32 = lane & 31, half = lane >> 5; unsigned char* ws = F.ws;
    const bf16* Qh = (const bf16*)(ws + WS_Q); const bf16* Kh = (const bf16*)(ws + WS_K); const bf16* Vh = (const bf16*)(ws + WS_V); float* PART = (float*)(ws + WS_PART);
    for (int wu = gw; wu < NB * NH * att::NT; wu += NGW) {
        const int bh = wu / att::NT, tile = wu % att::NT, j = tile * 64 + lane; const bool valid = j >= JOFF;
        const bf16* qp = Qh + ((size_t)bh * TK + 63) * QKD; const bf16* kp = Kh + ((size_t)bh * TK + j) * QKD;
        v4u qv[12], kv[12]; unsigned vv[32];
#pragma unroll
        for (int c = 0; c < 12; ++c) { qv[c] = *(const GAS v4u*)(qp + c * 8); kv[c] = *(const GAS v4u*)(kp + c * 8); }
        const unsigned* vp = (const unsigned*)(Vh + ((size_t)bh * TK + tile * 64 + 32 * half) * VD) + l32;
#pragma unroll
        for (int jj = 0; jj < 32; ++jj) vv[jj] = vp[jj * (VD / 2)];
        float s = 0.f;
#pragma unroll
        for (int c = 0; c < 12; ++c)
#pragma unroll
            for (int i = 0; i < 4; ++i) { s += __uint_as_float(qv[c][i] << 16) * __uint_as_float(kv[c][i] << 16); s += __uint_as_float(qv[c][i] & 0xffff0000u) * __uint_as_float(kv[c][i] & 0xffff0000u); }
        const float p = valid ? __builtin_amdgcn_exp2f(s) : 0.f; const float l = wave_sum(p);
        float a0 = 0.f, a1 = 0.f;
#pragma unroll
        for (int jj = 0; jj < 32; ++jj) { const float plo = __shfl(p, jj), phi = __shfl(p, jj + 32), pp_ = half ? phi : plo; a0 += pp_ * __uint_as_float(vv[jj] << 16); a1 += pp_ * __uint_as_float(vv[jj] & 0xffff0000u); }
        a0 += __shfl_xor(a0, 32); a1 += __shfl_xor(a1, 32);
        float* pp = PART + (size_t)bh * 66 * PT + tile; if (half == 0) { pp[(size_t)(2 * l32) * PT] = a0; pp[(size_t)(2 * l32 + 1) * PT] = a1; } if (lane == 0) pp[65 * PT] = l;
    }
}
__device__ __forceinline__ void row15_attn_combine(Frame& F, int bh) {
    unsigned char* ws = F.ws; const float* pp = (const float*)(ws + WS_PART) + (size_t)bh * 66 * PT; LAS float* red = (LAS float*)(F.lds + RING_OFF);
    const int w = F.wave, lane = F.lane, b = bh >> 3, h = bh & 7;
    float L = 0.f, O = 0.f;
#pragma unroll
    for (int k = 0; k < 17; ++k) { const int t = w + 8 * k; const bool ok = t < att::NT; const int tc = ok ? t : 0;
        const float lv = pp[65 * PT + tc], ov = pp[(size_t)lane * PT + tc]; L += ok ? lv : 0.f; O += ok ? ov : 0.f; }
    red[w * 65 + lane] = O; if (lane == 0) red[w * 65 + 64] = L;
    __syncthreads();
    if (w == 0) { float Os = 0.f, Ls = 0.f;
#pragma unroll
        for (int i = 0; i < NWAVES; ++i) { Os += red[i * 65 + lane]; Ls += red[i * 65 + 64]; }
        ((bf16*)(ws + WS_YN))[((size_t)b * T + 15) * D + LW + h * VD + lane] = (bf16)f2bf(Os / Ls); }
    __syncthreads();
}
constexpr size_t WS_RS = 208 * MiB;
__device__ __forceinline__ void ostat_phase(Frame& F, int cu0) {
    constexpr int RIF = 9;
    const int gw = (F.vcu - cu0) * NWAVES + F.wave, NGW = (F.G - cu0) * NWAVES, lane = F.lane; const bf16* YN = (const bf16*)(F.ws + WS_YN); float2* RS = (float2*)(F.ws + WS_RS);
    for (int base = gw; base < NB * SEQ; base += RIF * NGW) {
        size_t rows[RIF]; v4u vl[RIF], vm[RIF];
#pragma unroll
        for (int k = 0; k < RIF; ++k) { const int orow = base + k * NGW < NB * SEQ ? base + k * NGW : base; rows[k] = (size_t)(orow >> 13) * T + NMETA + (orow & (SEQ - 1));
            const GAS v4u* p = (const GAS v4u*)(YN + rows[k] * D + lane * 8); vl[k] = p[0]; vm[k] = p[64]; }
#pragma unroll
        for (int k = 0; k < RIF; ++k) { float sl = 0.f, sm = 0.f;
#pragma unroll
            for (int i = 0; i < 4; ++i) { const float a0 = __uint_as_float(vl[k][i] << 16), a1 = __uint_as_float(vl[k][i] & 0xffff0000u), b0 = __uint_as_float(vm[k][i] << 16), b1 = __uint_as_float(vm[k][i] & 0xffff0000u);
                sl += a0 * a0 + a1 * a1; sm += b0 * b0 + b1 * b1; }
            const float vm_ = wave_sum(sm) * (1.f / LW) + EPS; const float rl = __builtin_amdgcn_rsqf(wave_sum(sl) * (1.f / LW) + EPS), rm = __builtin_amdgcn_rsqf(vm_);
            if (lane == 0 && base + k * NGW < NB * SEQ) RS[rows[k]] = make_float2(rl * __builtin_amdgcn_sqrtf(vm_), rm); }
    }
}
__device__ __forceinline__ void attn_phase(Frame& F, const Args& args) {
    unsigned char* ws = F.ws; const bf16* Qh = (const bf16*)(ws + WS_Q); const bf16* Kh = (const bf16*)(ws + WS_K); const bf16* Vh = (const bf16*)(ws + WS_V); bf16* YN = (bf16*)(ws + WS_YN);
    for (int u = F.vcu; u < NB * NH * (SEQ / 256); u += F.G) {
        const int bh = (u & 255) >> 4, qb = (u & 15) + 16 * (u >> 8), b = bh >> 3, h = bh & 7;
        att::attn_unit(Qh + ((size_t)bh * TK + 64 + 256 * qb) * QKD, Kh + (size_t)bh * TK * QKD, Vh + (size_t)bh * TK * VD,
                       YN + ((size_t)b * T + NMETA + 256 * qb) * D + LW + h * VD, (LAS char*)(F.lds + RING_OFF));
    }
}
namespace mla {
using bf16x8 = __attribute__((ext_vector_type(8))) short;
using f32x16 = __attribute__((ext_vector_type(16))) float;
constexpr int RBLK = (T + 31) / 32;
constexpr int NBLK = NB * RBLK;
constexpr int QWP = 264, KWP = 136;
constexpr int MLA_BASE = 73216;
constexpr int QW_OFF = MLA_BASE, KW_OFF = QW_OFF + QKD * QWP * 2, MLA_LDS = KW_OFF + 128 * KWP * 2;
constexpr int GN_OFF = MLA_LDS;
static_assert(GN_OFF + 2 * QKD * 4 <= RING_BYTES, "mla lds");
__device__ __forceinline__ int crow(int r, int hi) { return (r & 3) + 8 * (r >> 2) + 4 * hi; }
__device__ __forceinline__ float bflo(unsigned w) { return __uint_as_float(w << 16); }
__device__ __forceinline__ float bfhi(unsigned w) { return __uint_as_float(w & 0xffff0000u); }
__device__ __forceinline__ float xsum(float v) { return v + __shfl_xor(v, 32); }
__device__ __forceinline__ u32x2 pk4(float a, float b, float c, float d) { u32x2 w; w.x = pk2(a, b); w.y = pk2(c, d); return w; }
__device__ __forceinline__ void st8pair(bf16* p, u32x2 A, u32x2 B, int hi, bool valid) {
    const auto s0 = __builtin_amdgcn_permlane32_swap(A.x, B.x, false, false), s1 = __builtin_amdgcn_permlane32_swap(A.y, B.y, false, false);
    const v4u w = {s0[0], s1[0], s0[1], s1[1]}; if (valid) *(GAS v4u*)(p + 8 * hi) = w; }
__device__ __forceinline__ bf16x8 norm8(bf16x8 x, float rstd, const float* g) {
    const v4u xv = __builtin_bit_cast(v4u, x); const f32x4 g0 = *(const GAS f32x4*)g, g1 = *(const GAS f32x4*)(g + 4);
    v4u o; o.x = pk2(bflo(xv.x) * rstd * g0[0], bfhi(xv.x) * rstd * g0[1]); o.y = pk2(bflo(xv.y) * rstd * g0[2], bfhi(xv.y) * rstd * g0[3]);
    o.z = pk2(bflo(xv.z) * rstd * g1[0], bfhi(xv.z) * rstd * g1[1]); o.w = pk2(bflo(xv.w) * rstd * g1[2], bfhi(xv.w) * rstd * g1[3]);
    return __builtin_bit_cast(bf16x8, o);
}
__device__ __forceinline__ float ss8(bf16x8 x) { const v4u v = __builtin_bit_cast(v4u, x); float s = 0.f;
#pragma unroll
    for (int i = 0; i < 4; ++i) { const float a = bflo(v[i]), b = bfhi(v[i]); s += a * a + b * b; } return s; }

__device__ __forceinline__ void unit(Frame& F, const Args& a, int blk, int h) {
    unsigned char* ws = F.ws; const int lane = F.lane, r32 = lane & 31, hi = lane >> 5;
    const int rb = blk % RBLK, b = blk / RBLK, t = rb * 32 + r32; const bool valid = t < T;
    const bf16* pr = (const bf16*)(ws + WS_PROJ) + ((size_t)b * T + t) * PROJW;
    const LAS bf16* Wq = (const LAS bf16*)(F.lds + RING_OFF + QW_OFF); const LAS bf16* Wk = (const LAS bf16*)(F.lds + RING_OFF + KW_OFF);
    const LAS float* gq = (const LAS float*)(F.lds + RING_OFF + GN_OFF); const LAS float* gk = gq + QKD;
    const float2* ropep = (const float2*)(ws + WS_ROPE) + (size_t)(valid ? t : 0) * 16 + 4 * hi;
    bf16x8 bq[16], bkv[8]; u32x2 kw1[2], kw2[2]; float2 rcs[8];
#pragma unroll
    for (int ks = 0; ks < 16; ++ks) bq[ks] = *(const GAS bf16x8*)(pr + 1024 + ks * 16 + hi * 8);
#pragma unroll
    for (int ks = 0; ks < 8; ++ks) bkv[ks] = *(const GAS bf16x8*)(pr + 1280 + ks * 16 + hi * 8);
#pragma unroll
    for (int g4 = 0; g4 < 2; ++g4) { const int i0 = 8 * g4 + 4 * hi; kw1[g4] = *(const GAS u32x2*)(pr + 1408 + i0); kw2[g4] = *(const GAS u32x2*)(pr + 1408 + 16 + i0); }
#pragma unroll
    for (int e = 0; e < 8; ++e) rcs[e] = ropep[8 * (e >> 2) + (e & 3)];
    const float lsq = ((const float*)(ws + WS_SSP))[(size_t)b * T + t], lskv = ((const float*)(ws + WS_SSP))[16640 + (size_t)b * T + t];
    __builtin_amdgcn_sched_barrier(0);
    {
        const float rq = __builtin_amdgcn_rsqf(lsq * (1.f / QL) + EPS);
        {
            bf16* Qo = (bf16*)(ws + WS_Q) + ((size_t)(b * NH + h) * TK + t + JOFF) * QKD;
            f32x16 acc[3] = {};
            const LAS bf16* wp = Wq + (size_t)r32 * QWP + hi * 8;
#pragma unroll
            for (int ks = 0; ks < 16; ++ks)
            { if ((ks & 3) == 0) __builtin_amdgcn_sched_barrier(0);
#pragma unroll
                for (int nb = 0; nb < 3; ++nb) acc[nb] = __builtin_amdgcn_mfma_f32_32x32x16_bf16(*(const LAS bf16x8*)(wp + nb * 32 * QWP + ks * 16), bq[ks], acc[nb], 0, 0, 0); }
            float ss = 0.f;
#pragma unroll
            for (int nb = 0; nb < 3; ++nb)
#pragma unroll
                for (int r = 0; r < 16; ++r) ss += acc[nb][r] * acc[nb][r];
            const float rs = rq * __builtin_amdgcn_rsqf(rq * rq * xsum(ss) * (1.f / QKD) + EPS) * (0.10206207261596575f * 1.4426950408889634f);
            u32x2 pq[2][4], pr1[2], pr2[2];
#pragma unroll
            for (int nb = 0; nb < 2; ++nb)
#pragma unroll
                for (int g4 = 0; g4 < 4; ++g4) { const int d0 = 32 * nb + 8 * g4 + 4 * hi; const f32x4 gg = *(const LAS f32x4*)(gq + d0);
                    pq[nb][g4] = pk4(acc[nb][4 * g4] * rs * gg[0], acc[nb][4 * g4 + 1] * rs * gg[1], acc[nb][4 * g4 + 2] * rs * gg[2], acc[nb][4 * g4 + 3] * rs * gg[3]); }
#pragma unroll
            for (int g4 = 0; g4 < 2; ++g4) { const int i0 = 8 * g4 + 4 * hi; const f32x4 ga = *(const LAS f32x4*)(gq + NOPE + i0), gb = *(const LAS f32x4*)(gq + NOPE + 16 + i0);
                float o1[4], o2[4];
#pragma unroll
                for (int e = 0; e < 4; ++e) { const float x1 = acc[2][4 * g4 + e] * rs * ga[e], x2 = acc[2][8 + 4 * g4 + e] * rs * gb[e]; const float2 cv = rcs[4 * g4 + e]; const float c = cv.x, s = cv.y;
                    o1[e] = x1 * c - x2 * s; o2[e] = x1 * s + x2 * c; }
                pr1[g4] = pk4(o1[0], o1[1], o1[2], o1[3]); pr2[g4] = pk4(o2[0], o2[1], o2[2], o2[3]); }
#pragma unroll
            for (int nb = 0; nb < 2; ++nb)
#pragma unroll
                for (int p = 0; p < 2; ++p) st8pair(Qo + 32 * nb + 16 * p, pq[nb][2 * p], pq[nb][2 * p + 1], hi, valid);
            st8pair(Qo + NOPE, pr1[0], pr1[1], hi, valid); st8pair(Qo + NOPE + 16, pr2[0], pr2[1], hi, valid);
        }
    }
    {
        const float rkv = __builtin_amdgcn_rsqf(lskv * (1.f / KVL) + EPS);
        float kp1[8], kp2[8]; float skp = 0.f;
#pragma unroll
        for (int g4 = 0; g4 < 2; ++g4) { const int i0 = 8 * g4 + 4 * hi;
            const u32x2 w1 = kw1[g4], w2 = kw2[g4];
            kp1[4 * g4 + 0] = bflo(w1.x); kp1[4 * g4 + 1] = bfhi(w1.x); kp1[4 * g4 + 2] = bflo(w1.y); kp1[4 * g4 + 3] = bfhi(w1.y);
            kp2[4 * g4 + 0] = bflo(w2.x); kp2[4 * g4 + 1] = bfhi(w2.x); kp2[4 * g4 + 2] = bflo(w2.y); kp2[4 * g4 + 3] = bfhi(w2.y); }
#pragma unroll
        for (int e = 0; e < 8; ++e) skp += kp1[e] * kp1[e] + kp2[e] * kp2[e];
        {
            const size_t orow = ((size_t)(b * NH + h) * TK + t + JOFF);
            bf16* Ko = (bf16*)(ws + WS_K) + orow * QKD; bf16* Vo = (bf16*)(ws + WS_V) + orow * VD;
            f32x16 acc[4] = {};
            const LAS bf16* wp = Wk + (size_t)r32 * KWP + hi * 8;
#pragma unroll
            for (int ks = 0; ks < 8; ++ks)
            { if ((ks & 3) == 0) __builtin_amdgcn_sched_barrier(0);
#pragma unroll
                for (int nb = 0; nb < 4; ++nb) acc[nb] = __builtin_amdgcn_mfma_f32_32x32x16_bf16(*(const LAS bf16x8*)(wp + nb * 32 * KWP + ks * 16), bkv[ks], acc[nb], 0, 0, 0); }
            float ss = 0.f;
#pragma unroll
            for (int nb = 0; nb < 2; ++nb)
#pragma unroll
                for (int r = 0; r < 16; ++r) ss += acc[nb][r] * acc[nb][r];
            const float rs = __builtin_amdgcn_rsqf(xsum(rkv * rkv * ss + skp) * (1.f / QKD) + EPS), rsn = rs * rkv;
            u32x2 pk_[2][4], pv_[2][4], pr1[2], pr2[2];
#pragma unroll
            for (int nb = 0; nb < 2; ++nb)
#pragma unroll
                for (int g4 = 0; g4 < 4; ++g4) { const int d0 = 32 * nb + 8 * g4 + 4 * hi; const f32x4 gg = *(const LAS f32x4*)(gk + d0);
                    pk_[nb][g4] = pk4(acc[nb][4 * g4] * rsn * gg[0], acc[nb][4 * g4 + 1] * rsn * gg[1], acc[nb][4 * g4 + 2] * rsn * gg[2], acc[nb][4 * g4 + 3] * rsn * gg[3]);
                    pv_[nb][g4] = pk4(acc[2 + nb][4 * g4] * rkv, acc[2 + nb][4 * g4 + 1] * rkv, acc[2 + nb][4 * g4 + 2] * rkv, acc[2 + nb][4 * g4 + 3] * rkv); }
#pragma unroll
            for (int g4 = 0; g4 < 2; ++g4) { const int i0 = 8 * g4 + 4 * hi; const f32x4 ga = *(const LAS f32x4*)(gk + NOPE + i0), gb = *(const LAS f32x4*)(gk + NOPE + 16 + i0);
                float o1[4], o2[4];
#pragma unroll
                for (int e = 0; e < 4; ++e) { const float x1 = kp1[4 * g4 + e] * rs * ga[e], x2 = kp2[4 * g4 + e] * rs * gb[e]; const float2 cv = rcs[4 * g4 + e]; const float c = cv.x, s = cv.y;
                    o1[e] = x1 * c - x2 * s; o2[e] = x1 * s + x2 * c; }
                pr1[g4] = pk4(o1[0], o1[1], o1[2], o1[3]); pr2[g4] = pk4(o2[0], o2[1], o2[2], o2[3]); }
#pragma unroll
            for (int nb = 0; nb < 2; ++nb)
#pragma unroll
                for (int p = 0; p < 2; ++p) { st8pair(Ko + 32 * nb + 16 * p, pk_[nb][2 * p], pk_[nb][2 * p + 1], hi, valid); st8pair(Vo + 32 * nb + 16 * p, pv_[nb][2 * p], pv_[nb][2 * p + 1], hi, valid); }
            st8pair(Ko + NOPE, pr1[0], pr1[1], hi, valid); st8pair(Ko + NOPE + 16, pr2[0], pr2[1], hi, valid);
        }
    }
}
__device__ __forceinline__ void stage(Frame& F, const Args& a, int h) {
    if (F.tid < 2 * QKD) ((LAS float*)(F.lds + RING_OFF + GN_OFF))[F.tid] = F.tid < QKD ? a.in[16][F.tid] : a.in[17][F.tid - QKD];
    const bf16* sq = (const bf16*)(F.ws + WS_WUQ) + (size_t)h * QKD * QL; const bf16* sk = (const bf16*)(F.ws + WS_WUKV) + (size_t)h * 128 * KVL; LAS unsigned char* dst = F.lds + RING_OFF;
    for (int cid = F.tid; cid < QKD * 32; cid += NWAVES * 64) { const int row = cid >> 5, piece = cid & 31; *(LAS v4u*)(dst + QW_OFF + (size_t)row * (QWP * 2) + piece * 16) = *(const GAS v4u*)(sq + (size_t)cid * 8); }
    for (int cid = F.tid; cid < 128 * 16; cid += NWAVES * 64) { const int row = cid >> 4, piece = cid & 15; *(LAS v4u*)(dst + KW_OFF + (size_t)row * (KWP * 2) + piece * 16) = *(const GAS v4u*)(sk + (size_t)cid * 8); }
}
}
namespace lru {
using bf16x8 = __attribute__((ext_vector_type(8))) short;
constexpr int CL = 80, NSC = CL / 16, NCH = (T + CL - 1) / CL, NUNITS = NB * NH * NCH;
constexpr int XCP = 68;
constexpr int WAVE_LDS = 16 * XCP * 4;
constexpr size_t WS_LSUM = 241 * MiB;
constexpr size_t WS_LSUB = 243 * MiB;
static_assert(NWAVES * WAVE_LDS <= RING_BYTES && WS_LSUM + (size_t)NB * 2 * NCH * 1024 * 4 <= WS_LSUB && WS_LSUB + (size_t)NB * NCH * NSC * 1024 * 4 <= 256 * MiB, "lru maps");

constexpr int WL_OFF = NWAVES * WAVE_LDS, WLP = 72;
constexpr int CST_OFF = WL_OFF + 4 * 64 * WLP * 2;
constexpr int CBL_OFF = CST_OFF + 6 * 64 * 4;
static_assert(CBL_OFF + NWAVES * NSC * 256 <= RING_BYTES, "lru lds");
__device__ __forceinline__ void gate4(const LAS float* XC, const LAS bf16* WLs, const LAS float* CST, const bf16x8 (&af)[2], int dir, int nb, int fr, int fq, float (&av)[4], float (&uv)[4]) {
    f32x4 accA = {0.f, 0.f, 0.f, 0.f}, accX = {0.f, 0.f, 0.f, 0.f};
    const LAS bf16* wl = WLs + (size_t)(dir * 64 + 16 * nb + fr) * WLP + fq * 8;
#pragma unroll
    for (int ks = 0; ks < 2; ++ks) { accA = __builtin_amdgcn_mfma_f32_16x16x32_bf16(af[ks], *(const LAS bf16x8*)(wl + ks * 32), accA, 0, 0, 0);
        accX = __builtin_amdgcn_mfma_f32_16x16x32_bf16(af[ks], *(const LAS bf16x8*)(wl + 2 * 64 * WLP + ks * 32), accX, 0, 0, 0); }
    const int cl = 16 * nb + fr; const float ba = CST[dir * 64 + cl], bx = CST[(2 + dir) * 64 + cl], spv = CST[(4 + dir) * 64 + cl];
#pragma unroll
    for (int r = 0; r < 4; ++r) { const int s = 4 * fq + r;
        const float rg = frcp(1.f + __builtin_amdgcn_exp2f(fmaf(accA[r], -1.4426950408889634f, ba))), ig = frcp(1.f + __builtin_amdgcn_exp2f(fmaf(accX[r], -1.4426950408889634f, bx)));
        const float a_ = __builtin_amdgcn_exp2f(rg * spv), u_ = __builtin_amdgcn_sqrtf(fmaf(-a_, a_, 1.f)) * ig * XC[s * XCP + 16 * nb + fr];
        av[r] = a_; uv[r] = u_; }
}
template <bool FINAL>
__device__ __forceinline__ void unit(Frame& F, const Args& a, int h, int bc) {
    unsigned char* ws = F.ws; const int lane = F.lane, fr = lane & 15, fq = lane >> 4;
    const int ck = bc % NCH, b = bc / NCH, t0 = ck * CL, tend = (t0 + CL < T) ? t0 + CL : T;
    const bool part = __builtin_amdgcn_readfirstlane(ck) == NCH - 1;
    LAS float* XC = (LAS float*)(F.lds + RING_OFF + F.wave * WAVE_LDS); const LAS bf16* WLs = (const LAS bf16*)(F.lds + RING_OFF + WL_OFF);
    const bf16* PROJ = (const bf16*)(ws + WS_PROJ); float* LSUM = (float*)(ws + WS_LSUM); float* LSUB = (float*)(ws + WS_LSUB); bf16* YN = (bf16*)(ws + WS_YN);
    const LAS float* CST = (const LAS float*)(F.lds + RING_OFF + CST_OFF); LAS float* CBL = (LAS float*)(F.lds + RING_OFF + CBL_OFF) + F.wave * (NSC * 64);
    const int cch = 64 * h + lane;
    const bf16* xcol = PROJ + (size_t)b * T * PROJW + cch;
    const float cw0 = a.in[4][cch], cw1 = a.in[4][LW + cch], cw2 = a.in[4][2 * LW + cch], cw3 = a.in[4][3 * LW + cch], cbias = a.in[5][cch];
    float hf[4] = {0.f, 0.f, 0.f, 0.f}, af_[4] = {1.f, 1.f, 1.f, 1.f}, Ab[4] = {1.f, 1.f, 1.f, 1.f}, Hb[4] = {0.f, 0.f, 0.f, 0.f};
    float sa[NSC], sh[NSC];
    if (FINAL) {
        const float* sb = LSUB + ((size_t)(b * NCH + ck) * NSC) * 1024 + 64 * h + lane;
#pragma unroll
        for (int j = 1; j < NSC; ++j) { sa[j] = sb[(size_t)j * 1024]; sh[j] = sb[(size_t)j * 1024 + 512]; }
    }
    float xv[19];
#pragma unroll
    for (int i = 0; i < 19; ++i) { const int t = t0 - 2 + i, tc = t < 0 ? 0 : t; const float v = bf2f(xcol[(size_t)tc * PROJW]); xv[i] = (t >= 0 && t < T) ? v : 0.f; }
    if (FINAL) {
        const float2* smf = (const float2*)LSUM + ((size_t)(b * 2 + 0) * NCH) * 512 + 64 * h + lane; const float2* smb = (const float2*)LSUM + ((size_t)(b * 2 + 1) * NCH) * 512 + 64 * h + lane;
        float xf = 0.f, xb = 0.f;
        static_assert((NCH - 1) % 34 == 0, "fold batching");
#pragma unroll 34
        for (int j = 0; j < NCH - 1; ++j) {
            const bool isf = j < ck; const int idx = isf ? j : (NCH - 1) - (j - ck); const float2 v = (isf ? smf : smb)[(size_t)idx * 512];
            if (isf) xf = v.x * xf + v.y; else xb = v.x * xb + v.y; }
#pragma unroll
        for (int nb = 0; nb < 4; ++nb) hf[nb] = __shfl(xf, 16 * nb + fr);
        CBL[(NSC - 1) * 64 + lane] = xb;
#pragma unroll
        for (int j = NSC - 1; j > 0; --j) { xb = sa[j] * xb + sh[j]; CBL[(j - 1) * 64 + lane] = xb; }
    }
#pragma unroll 1
    for (int sc = 0; sc < NSC; ++sc) {
        const int ts = t0 + 16 * sc, nvalid = tend - ts;
#pragma unroll
        for (int s = 0; s < 16; ++s) XC[s * XCP + lane] = cbias + cw0 * xv[s] + cw1 * xv[s + 1] + cw2 * xv[s + 2] + cw3 * xv[s + 3];
        if (part) {
#pragma unroll
            for (int s = 0; s < 16; ++s) if (s >= nvalid) XC[s * XCP + lane] = 0.f; }
        if (sc + 1 < NSC) {
            xv[0] = xv[16]; xv[1] = xv[17]; xv[2] = xv[18];
#pragma unroll
            for (int i = 3; i < 19; ++i) { const int t = ts + 14 + i; const float v = bf2f(xcol[(size_t)t * PROJW]); xv[i] = (t < T) ? v : 0.f; }
        }
        unsigned gl[4][2];
        if (FINAL) {
#pragma unroll
            for (int nb = 0; nb < 4; ++nb)
#pragma unroll
                for (int rp = 0; rp < 2; ++rp) { const int s0 = 4 * fq + 2 * rp; const bf16* gp = PROJ + ((size_t)b * T + ts + s0) * PROJW + LW + 64 * h + 16 * nb + fr;
                    const unsigned lo = gp[0], hi = gp[PROJW]; gl[nb][rp] = lo | (hi << 16); }
        }
        asm volatile("s_waitcnt lgkmcnt(0)" ::: "memory");
        bf16x8 af[2];
#pragma unroll
        for (int ks = 0; ks < 2; ++ks) { const LAS f32x4* xp = (const LAS f32x4*)(XC + fr * XCP + 32 * ks + 8 * fq); const f32x4 x0 = xp[0], x1 = xp[1];
            v4u w; w.x = pk2(x0[0], x0[1]); w.y = pk2(x0[2], x0[3]); w.z = pk2(x1[0], x1[1]); w.w = pk2(x1[2], x1[3]); af[ks] = __builtin_bit_cast(bf16x8, w); }
        float hfs[4][4];
#pragma unroll
        for (int nb = 0; nb < 4; ++nb) {
            float av[4], uv[4]; gate4(XC, WLs, CST, af, 0, nb, fr, fq, av, uv);
            float A = av[0], H = uv[0];
#pragma unroll
            for (int r = 1; r < 4; ++r) { H = av[r] * H + uv[r]; A *= av[r]; }
            const float A0 = __shfl(A, fr), H0 = __shfl(H, fr), A1 = __shfl(A, fr + 16), H1 = __shfl(H, fr + 16), A2 = __shfl(A, fr + 32), H2 = __shfl(H, fr + 32), A3 = __shfl(A, fr + 48), H3 = __shfl(H, fr + 48);
            const float S0 = hf[nb], S1 = A0 * S0 + H0, S2 = A1 * S1 + H1, S3 = A2 * S2 + H2;
            hf[nb] = A3 * S3 + H3;
            if (FINAL) { float x = fq == 0 ? S0 : fq == 1 ? S1 : fq == 2 ? S2 : S3;
#pragma unroll
                for (int r = 0; r < 4; ++r) { x = av[r] * x + uv[r]; hfs[nb][r] = x; } }
            else af_[nb] *= (A0 * A1) * (A2 * A3);
        }
#pragma unroll
        for (int nb = 0; nb < 4; ++nb) {
            float av[4], uv[4]; gate4(XC, WLs, CST, af, 1, nb, fr, fq, av, uv);
            float A = av[3], H = uv[3];
#pragma unroll
            for (int r = 2; r >= 0; --r) { H = av[r] * H + uv[r]; A *= av[r]; }
            const float A0 = __shfl(A, fr), H0 = __shfl(H, fr), A1 = __shfl(A, fr + 16), H1 = __shfl(H, fr + 16), A2 = __shfl(A, fr + 32), H2 = __shfl(H, fr + 32), A3 = __shfl(A, fr + 48), H3 = __shfl(H, fr + 48);
            if (!FINAL) {
                const float al = (A0 * A1) * (A2 * A3), hl = A0 * (A1 * (A2 * H3 + H2) + H1) + H0;
                if (fq == 0) { float* sb = LSUB + ((size_t)(b * NCH + ck) * NSC + sc) * 1024 + 64 * h + 16 * nb + fr; sb[0] = al; sb[512] = hl; }
                Hb[nb] += Ab[nb] * hl; Ab[nb] *= al;
            } else {
                const float S3 = CBL[sc * 64 + 16 * nb + fr];
                const float S2 = A3 * S3 + H3, S1 = A2 * S2 + H2, S0 = A1 * S1 + H1;
                float x = fq == 0 ? S0 : fq == 1 ? S1 : fq == 2 ? S2 : S3;
#pragma unroll
                for (int r = 3; r >= 0; --r) { x = av[r] * x + uv[r];
                    const int s = 4 * fq + r;
                    const float gv = (r & 1) ? __uint_as_float(gl[nb][r >> 1] & 0xffff0000u) : __uint_as_float(gl[nb][r >> 1] << 16);
                    if (!part || s < nvalid) YN[((size_t)b * T + ts + s) * D + 64 * h + 16 * nb + fr] = (bf16)f2bf((hfs[nb][r] + x) * gelu_tanh(gv)); }
            }
        }
    }
    if (!FINAL && fq == 0) {
#pragma unroll
        for (int nb = 0; nb < 4; ++nb) { float2* sm = (float2*)LSUM + ((size_t)(b * 2) * NCH + ck) * 512 + 64 * h + 16 * nb + fr; sm[0] = make_float2(af_[nb], hf[nb]); sm[(size_t)NCH * 512] = make_float2(Ab[nb], Hb[nb]); }
    }
}
__device__ __forceinline__ void stage(Frame& F, const Args& a, int h) {
    const bf16* WL = (const bf16*)(F.ws + WS_WL); LAS unsigned char* dst = F.lds + RING_OFF + WL_OFF;
#pragma unroll
    for (int i = 0; i < 4; ++i) { const int cid = F.tid + 512 * i, m4 = cid >> 9, row = (cid >> 3) & 63, piece = cid & 7;
        *(LAS v4u*)(dst + (size_t)(m4 * 64 + row) * (WLP * 2) + piece * 16) = *(const GAS v4u*)(WL + (size_t)(m4 * 8 + h) * 4096 + row * 64 + piece * 8); }
    if (F.tid < 6 * 64) { const int kind = F.tid >> 7, dir = (F.tid >> 6) & 1, c = F.tid & 63; const float* src = kind == 0 ? a.in[7] : kind == 1 ? a.in[9] : (const float*)(F.ws + WS_SP);
        ((LAS float*)(F.lds + RING_OFF + CST_OFF))[F.tid] = src[dir * LW + 64 * h + c] * (kind == 2 ? -8.f * 1.4426950408889634f : -1.4426950408889634f); }
}
static_assert(CST_OFF + 6 * 64 * 4 <= 73216, "LRU pass-1 region below the MLA weights");
}
__device__ __forceinline__ void p0_tr_item(const float* W, int K, int N, bf16* WT, LAS float* scr, int item, int lane, const float* gk, int upperm) {
    const int nblk = N / 32, kb = item / nblk, nb = item % nblk, k0 = 64 * kb, n0 = 32 * nb;
    float wv[32];
#pragma unroll
    for (int i = 0; i < 32; ++i) wv[i] = __builtin_nontemporal_load(W + (size_t)(k0 + 2 * i + (lane >> 5)) * N + n0 + (lane & 31));
#pragma unroll
    for (int i = 0; i < 32; ++i) { const int kk = 2 * i + (lane >> 5); float w = wv[i]; if (gk) w *= gk[k0 + kk]; scr[kk * 33 + (lane & 31)] = w; }
    LDS_WAIT(); asm volatile("" ::: "memory");
    int orow0 = n0; if (upperm) { const int half = n0 / FF, cidx = n0 % FF; orow0 = (cidx / 128) * 256 + half * 128 + (cidx % 128); }
    const int c = lane & 7;
#pragma unroll
    for (int j = 0; j < 4; ++j) { const int n = (lane >> 3) + 8 * j; const LAS float* s = scr + (8 * c) * 33 + n;
        v4u o; o.x = pk2(s[0 * 33], s[1 * 33]); o.y = pk2(s[2 * 33], s[3 * 33]); o.z = pk2(s[4 * 33], s[5 * 33]); o.w = pk2(s[6 * 33], s[7 * 33]);
        *(GAS v4u*)(WT + (size_t)(orow0 + n) * K + k0 + 8 * c) = o; }
    LDS_WAIT(); asm volatile("" ::: "memory");
}
__device__ __forceinline__ void p0_hn_row(const float* xrow, const float* g, bf16* orow, int lane) {
    const GAS f32x4* xr = (const GAS f32x4*)xrow + lane;
    f32x4 v[4]; float s = 0.f;
#pragma unroll
    for (int j = 0; j < 4; ++j) { v[j] = xr[64 * j]; s += (v[j].x * v[j].x + v[j].y * v[j].y) + (v[j].z * v[j].z + v[j].w * v[j].w); }
    const float rstd = 1.f / sqrtf(wave_sum(s) * (1.f / D) + EPS);
    GAS unsigned long long* o8 = (GAS unsigned long long*)orow + lane;
#pragma unroll
    for (int j = 0; j < 4; ++j) { const f32x4 gg = ((const GAS f32x4*)g)[lane + 64 * j];
        o8[64 * j] = (unsigned long long)pk2(v[j].x * rstd * gg.x, v[j].y * rstd * gg.y) | ((unsigned long long)pk2(v[j].z * rstd * gg.z, v[j].w * rstd * gg.w) << 32); }
}
__device__ __forceinline__ void p0_prologue(Frame& F, const Args& a) {
    LAS float* scr = (LAS float*)(F.lds + RING_OFF + F.wave * 16384);
    const int gw = F.vcu * NWAVES + F.wave, NGW = F.G * NWAVES;
    unsigned char* ws = F.ws;
    constexpr int I_IN = 16 * 45, I_UQ = 4 * 24, I_UKV = 2 * 32, I_L = 64;
    constexpr int NITEMS = I_IN + I_UQ + I_UKV + I_L;
    for (int it = gw; it < NITEMS; it += NGW) {
        int r = it;
        if (r < I_IN) { p0_tr_item(a.in[3], D, INC, (bf16*)(ws + WS_WIN), scr, r, F.lane, nullptr, 0); continue; } r -= I_IN;
        if (r < I_UQ) { p0_tr_item(a.in[13], QL, NH * QKD, (bf16*)(ws + WS_WUQ), scr, r, F.lane, a.in[12], 0); continue; } r -= I_UQ;
        if (r < I_UKV) { p0_tr_item(a.in[15], KVL, NH * 128, (bf16*)(ws + WS_WUKV), scr, r, F.lane, a.in[14], 0); continue; } r -= I_UKV;
        { const int m = r >> 1, gate = m >> 4, dh = m & 15;
          p0_tr_item((gate ? a.in[8] : a.in[6]) + (size_t)dh * 4096, 64, 64, (bf16*)(ws + WS_WL) + (size_t)m * 4096, scr, r & 1, F.lane, nullptr, 0); }
    }
    bf16* HN = (bf16*)(ws + WS_HN);
    f32x4 ggv[4];
#pragma unroll
    for (int j = 0; j < 4; ++j) ggv[j] = ((const GAS f32x4*)a.in[2])[F.lane + 64 * j];
    for (int m = gw; m < NRP; m += 2 * NGW) {
        const int m2 = m + NGW;
        if (m2 < NR) {
            const GAS f32x4* x0 = (const GAS f32x4*)h0_row(a.in[0], a.in[1], m) + F.lane; const GAS f32x4* x1 = (const GAS f32x4*)h0_row(a.in[0], a.in[1], m2) + F.lane;
            f32x4 v0[4], v1[4]; float s0 = 0.f, s1 = 0.f;
#pragma unroll
            for (int j = 0; j < 4; ++j) { v0[j] = __builtin_nontemporal_load(x0 + 64 * j); v1[j] = __builtin_nontemporal_load(x1 + 64 * j); }
#pragma unroll
            for (int j = 0; j < 4; ++j) { s0 += (v0[j].x * v0[j].x + v0[j].y * v0[j].y) + (v0[j].z * v0[j].z + v0[j].w * v0[j].w); s1 += (v1[j].x * v1[j].x + v1[j].y * v1[j].y) + (v1[j].z * v1[j].z + v1[j].w * v1[j].w); }
            const float r0 = __builtin_amdgcn_rsqf(wave_sum(s0) * (1.f / D) + EPS), r1 = __builtin_amdgcn_rsqf(wave_sum(s1) * (1.f / D) + EPS);
            GAS unsigned long long* o0 = (GAS unsigned long long*)(HN + (size_t)m * D) + F.lane; GAS unsigned long long* o1 = (GAS unsigned long long*)(HN + (size_t)m2 * D) + F.lane;
#pragma unroll
            for (int j = 0; j < 4; ++j) { const f32x4 gg = ggv[j];
                o0[64 * j] = (unsigned long long)pk2(v0[j].x * r0 * gg.x, v0[j].y * r0 * gg.y) | ((unsigned long long)pk2(v0[j].z * r0 * gg.z, v0[j].w * r0 * gg.w) << 32);
                o1[64 * j] = (unsigned long long)pk2(v1[j].x * r1 * gg.x, v1[j].y * r1 * gg.y) | ((unsigned long long)pk2(v1[j].z * r1 * gg.z, v1[j].w * r1 * gg.w) << 32); }
        } else for (int mm = m; mm < NRP && mm <= m2; mm += NGW) {
            if (mm < NR) p0_hn_row(h0_row(a.in[0], a.in[1], mm), a.in[2], HN + (size_t)mm * D, F.lane);
            else { GAS unsigned long long* o8 = (GAS unsigned long long*)(HN + (size_t)mm * D) + F.lane; for (int j = 0; j < 4; ++j) o8[64 * j] = 0ull; } }
    }
    const int gid = F.vcu * (NWAVES * 64) + F.tid, gsz = F.G * NWAVES * 64;
    float2* rope = (float2*)(ws + WS_ROPE);
    for (int i = gid; i < T * 16; i += gsz) {
        const int t = i >> 4, j = i & 15;
        const float inv_freq = rope_inv_freq(j);
        const float ang = (float)t * inv_freq;
        double s, c; sincos_d((double)ang, s, c);
        rope[i] = make_float2((float)c, (float)s);
    }
    float* sp = (float*)(ws + WS_SP);
    for (int i = gid; i < 2 * LW; i += gsz) sp[i] = (float)log1p(exp(-(double)a.in[10][i]));
    { v4u z = {0u, 0u, 0u, 0u}; GAS v4u* wz = (GAS v4u*)(ws + WS_WIN + (size_t)INC * D * 2); for (int i = gid; i < (PROJW - INC) * D * 2 / 16; i += gsz) wz[i] = z; }
    bf16* Q = (bf16*)(ws + WS_Q); bf16* K = (bf16*)(ws + WS_K); bf16* V = (bf16*)(ws + WS_V);
    for (int i = gid; i < NB * NH * JOFF * QKD; i += gsz) { const int bh = i / (JOFF * QKD), r = i % (JOFF * QKD); Q[(size_t)bh * TK * QKD + r] = 0; K[(size_t)bh * TK * QKD + r] = 0; }
    for (int i = gid; i < NB * NH * JOFF * VD; i += gsz) { const int bh = i / (JOFF * VD), r = i % (JOFF * VD); V[(size_t)bh * TK * VD + r] = 0; }
}


constexpr int CW_CONV = 2048;
__device__ __forceinline__ void p2_phase(Frame& F, const Args& a) {
    const int h = F.vcu & 7, cg = F.vcu >> 3, ncg = F.G >> 3;
    lru::stage(F, a, h); mla::stage(F, a, h);
    if (F.tid == 0) F.MISC[4] = 0u;
    __syncthreads();
    { const int bc = F.wave * ncg + cg; if (bc < NB * lru::NCH) lru::unit<false>(F, a, h, bc); }
    for (;;) { unsigned i = 0; if (F.lane == 0) i = __hip_atomic_fetch_add((LAS unsigned*)&F.MISC[4], 1u, __ATOMIC_RELAXED, __HIP_MEMORY_SCOPE_WORKGROUP);
        i = __builtin_amdgcn_readfirstlane(i); const int blk = cg + ncg * (int)i; if (blk >= mla::NBLK) break; mla::unit(F, a, blk, h); }
    __syncthreads();
}

struct TrRegs { f32x4 v[8]; float g[8]; };
__device__ __forceinline__ void tr_pick(const Args& a, unsigned char* ws, int it, const float*& W, int& K, int& N, bf16*& WT, const float*& gk, int& up, int& r, int I_UP, int I_DN) {
    r = it;
    if (r < I_UP) { W = a.in[21]; K = D; N = 2 * FF; WT = (bf16*)(ws + WS_WUP); gk = a.in[20]; up = 1; return; } r -= I_UP;
    if (r < I_DN) { W = a.in[24]; K = FF; N = D; WT = (bf16*)(ws + WS_WDN); gk = nullptr; up = 0; return; } r -= I_DN;
    W = a.in[19]; K = D; N = D; WT = (bf16*)(ws + WS_WOUT); gk = (r / (D / 32)) * 64 < LW ? a.in[11] : a.in[18] - LW; up = 0;
}
__device__ __forceinline__ void tr_load(const float* W, int N, int r, int lane, const float* gk, TrRegs& t) {
    const int nblk = N / 32, kb = r / nblk, nb = r % nblk, k0 = 64 * kb, n0 = 32 * nb;
#pragma unroll
    for (int i = 0; i < 8; ++i) { const int kk = 8 * i + (lane >> 3); t.v[i] = __builtin_nontemporal_load((const GAS f32x4*)(W + (size_t)(k0 + kk) * N + n0 + 4 * (lane & 7)))  ; }
#pragma unroll
    for (int i = 0; i < 8; ++i) t.g[i] = gk ? gk[k0 + 8 * i + (lane >> 3)] : 1.f;
}
__device__ __forceinline__ void tr_finish(int K, int N, bf16* WT, LAS float* scr, int r, int lane, int upperm, const TrRegs& t) {
    const int nblk = N / 32, kb = r / nblk, nb = r % nblk, k0 = 64 * kb, n0 = 32 * nb;
#pragma unroll
    for (int i = 0; i < 8; ++i) { const int kk = 8 * i + (lane >> 3); LAS float* d = scr + kk * 33 + 4 * (lane & 7); const f32x4 w = t.v[i] * t.g[i]; d[0] = w[0]; d[1] = w[1]; d[2] = w[2]; d[3] = w[3]; }
    LDS_WAIT(); asm volatile("" ::: "memory");
    int orow0 = n0; if (upperm) { const int half = n0 / FF, cidx = n0 % FF; orow0 = (cidx / 128) * 256 + half * 128 + (cidx % 128); }
    const int c = lane & 7;
#pragma unroll
    for (int j = 0; j < 4; ++j) { const int n = (lane >> 3) + 8 * j; const LAS float* s = scr + (8 * c) * 33 + n;
        v4u o; o.x = pk2(s[0 * 33], s[1 * 33]); o.y = pk2(s[2 * 33], s[3 * 33]); o.z = pk2(s[4 * 33], s[5 * 33]); o.w = pk2(s[6 * 33], s[7 * 33]);
        *(GAS v4u*)(WT + (size_t)(orow0 + n) * K + k0 + 8 * c) = o; }
    LDS_WAIT(); asm volatile("" ::: "memory");
}
__device__ __forceinline__ void p3_phase(Frame& F, const Args& a) {
    const int h = F.vcu & 7, cg = F.vcu >> 3, ncg = F.G >> 3;
    lru::stage(F, a, h);
    __syncthreads();
    { const int bc = F.wave * ncg + cg; if (bc < NB * lru::NCH) lru::unit<true>(F, a, h, bc); }
    row15_attn_partials(F);
    LAS float* scr = (LAS float*)(F.lds + RING_OFF + 88064 + F.wave * 8448); unsigned char* ws = F.ws;
    constexpr int IDLE_ITEMS = 12;
    constexpr int I_OUT = 16 * 32, I_UP = 16 * 176, I_DN = 44 * 32, NITEMS = I_OUT + I_UP + I_DN;
    { const int slot = F.wave * ncg + cg, nbusy = NB * lru::NCH * 8, nidle = (NWAVES * ncg - NB * lru::NCH) * 8; const bool busy = slot < NB * lru::NCH;
      const int me = busy ? slot * 8 + h : (slot - NB * lru::NCH) * 8 + h, nme = busy ? nbusy : nidle, first = busy ? (IDLE_ITEMS * nidle < NITEMS ? IDLE_ITEMS * nidle : NITEMS) : 0, last = busy ? NITEMS : (IDLE_ITEMS * nidle < NITEMS ? IDLE_ITEMS * nidle : NITEMS);
      const float* W; int K, N, up, r; bf16* WT; const float* gk; TrRegs cur, nxt;
      int it = first + me;
      if (it < last) { tr_pick(a, ws, it, W, K, N, WT, gk, up, r, I_UP, I_DN); tr_load(W, N, r, F.lane, gk, cur); }
      while (it < last) { const int itn = it + nme; const float* W2 = W; int K2 = K, N2 = N, up2 = up, r2 = r; bf16* WT2 = WT; const float* gk2 = gk;
        if (itn < last) { tr_pick(a, ws, itn, W2, K2, N2, WT2, gk2, up2, r2, I_UP, I_DN); tr_load(W2, N2, r2, F.lane, gk2, nxt); }
        tr_finish(K, N, WT, scr, r, F.lane, up, cur);
        it = itn; W = W2; K = K2; N = N2; up = up2; r = r2; WT = WT2; gk = gk2;
#pragma unroll
        for (int i = 0; i < 8; ++i) { cur.v[i] = nxt.v[i]; cur.g[i] = nxt.g[i]; } } }
    __syncthreads();
}
__global__ void __launch_bounds__(NWAVES * 64, 2) mega_fwd(Args args) {
    extern __shared__ __attribute__((aligned(16))) unsigned char lds[];
    Frame F;
    F.lds = (LAS unsigned char*)lds; F.MISC = (volatile LAS unsigned*)(F.lds + MISC_OFF);
    F.tid = threadIdx.x; F.lane = F.tid & 63; F.wave = __builtin_amdgcn_readfirstlane(F.tid >> 6);
    F.G = gridDim.x; { const int bx = blockIdx.x; F.vcu = (F.G % 8 == 0) ? (bx % 8) * (F.G / 8) + bx / 8 : bx; }
    F.ws = args.ws; F.ctl = (gu32*)(args.ws + WS_CTL);
    for (int u = F.tid; u < (LDS_BYTES - LDSCTL_OFF) / 4; u += NWAVES * 64) ((LAS unsigned*)(F.lds + LDSCTL_OFF))[u] = 0u;
    __syncthreads();
    XcdBarrier bar = xcd_barrier_post((unsigned*)(F.ctl + CW_BAR) + args.bar_region * XCD_BAR_WORDS, F.MISC + 8);
    const int lo = args.ph_lo, hi = args.ph_hi;
#define IN(k) (lo <= (k) && (k) < hi)
#define BOTH(k) (IN(k) && IN((k) + 1))
#define GRID_BAR() xcd_barrier(bar)
    unsigned char* ws = args.ws;
    if (IN(0)) { p0_prologue(F, args); if (BOTH(0)) GRID_BAR(); }
    if (IN(1)) {
        pg8::Gemm g{(const bf16_t*)(ws + WS_HN), (const bf16_t*)(ws + WS_WIN), NRP, PROJW, D, 0}; pg8::StaticOrder S; S.init(NRP, PROJW, F.G, (int)blockIdx.x);
        pg8::EpiProj E{(bf16_t*)(ws + WS_PROJ), PROJW, (float*)(ws + WS_SSP), (LAS float*)(F.lds + EPI_SCR_OFF)};
        pg8::gemm_phase<pg8::EpiProj, pg8::StaticOrder, true, PG8_SP2>(F.lds + RING_OFF, g, S, E);
        if (BOTH(1)) GRID_BAR();
    }

    if (IN(2)) { p2_phase(F, args); if (BOTH(2)) GRID_BAR(); }
    if (IN(3)) { p3_phase(F, args); }
    if (IN(4)) { attn_phase(F, args); if (BOTH(4)) GRID_BAR(); }
    if (IN(5)) { if (F.vcu < NB * NH) row15_attn_combine(F, F.vcu); else ostat_phase(F, NB * NH); if (BOTH(5)) GRID_BAR(); }
    if (IN(6)) {
        row15_outproj(F, args);
        pg8::Gemm g{(const bf16_t*)(ws + WS_YN), (const bf16_t*)(ws + WS_WOUT), NB * SEQ, D, D, 1}; pg8::StaticOrder S; S.init(NB * SEQ, D, F.G, (int)blockIdx.x);
        pg8::EpiOut E{args.in[0], args.out, (bf16_t*)(ws + WS_H1B), (float*)(ws + WS_SSP), (LAS float*)(F.lds + EPI_SCR_OFF), (const float2*)(ws + WS_RS)};
        pg8::gemm_phase<pg8::EpiOut, pg8::StaticOrder, true, PG8_SP2>(F.lds + RING_OFF, g, S, E);
        if (BOTH(6)) GRID_BAR();
    }
    if (IN(7)) {
        row15_gate(F);
        pg8::Gemm g{(const bf16_t*)(ws + WS_H1B), (const bf16_t*)(ws + WS_WUP), NB * SEQ, 2 * FF, D, 1}; pg8::StaticOrderLim S; S.init(NB * SEQ, 2 * FF, F.G, (int)blockIdx.x);
        const int bx = blockIdx.x, nfull = S.nwg / F.G; const bool split = (F.G & 15) == 0 && S.nwg % F.G == F.G / 2;
        const int kh = (bx >> 3) & 1; pg8::Unit su; su.pm = 0; su.pn = 0; su.idx = nfull;
        S.maxr = split ? nfull : 0x7fffffff;
        if (split) { pg8::StaticOrder S2 = S; S2.c = (bx & 7) + 8 * (bx >> 4); S2.next(nfull, su); }
        { LAS float* RL = (LAS float*)(F.lds + EPI_SCR_OFF); const float* SSP = (const float*)(ws + WS_SSP); pg8::Unit uu;
          int t_ = threadIdx.x; asm volatile("" : "+v"(t_));
          for (int i = 0; i <= nfull; ++i) { if (i < nfull) { if (!S.next(i, uu)) break; } else { if (split) uu = su; else if (!S.next(i, uu)) break; } if (t_ < 256) { const size_t row = pg8::tile_row0(1, uu.pm) + t_;
              const float ss = (SSP[row] + SSP[16640 + row]) + (SSP[2 * 16640 + row] + SSP[3 * 16640 + row]); RL[i * 256 + t_] = __builtin_amdgcn_rsqf(ss * (1.0f / 1024.0f) + 1e-6f); } }
          __syncthreads(); }
        pg8::EpiUpActT<false> E{(LAS const float*)(F.lds + EPI_SCR_OFF), (bf16_t*)(ws + WS_U), (bf16_t*)(ws + WS_GS), (bf16_t*)(ws + WS_US), args.in[22], args.in[23], 0};
        pg8::gemm_phase<pg8::EpiUpActT<false>, pg8::StaticOrderLim, PG8_ALIGN, PG8_SP2>(F.lds + RING_OFF, g, S, E);
        static_assert(EPI_SCR_OFF + 6 * 1024 <= pg8::XBUF9 && pg8::XBUF9 + 16384 <= RING_BYTES, "ninth stage buffer");
        if (split) {
            pg8::HalfOrder HO{su.pm, su.pn, nfull, kh};
            pg8::EpiUpActT<true> EH{(LAS const float*)(F.lds + EPI_SCR_OFF), (bf16_t*)(ws + WS_U), (bf16_t*)(ws + WS_GS), (bf16_t*)(ws + WS_US), args.in[22], args.in[23], kh};
            pg8::gemm_phase<pg8::EpiUpActT<true>, pg8::HalfOrder, true, PG8_SP2>(F.lds + RING_OFF, g, HO, EH);
        }
        if (BOTH(7) || (IN(7) && IN(9))) GRID_BAR();
    }
    if (IN(9)) {
        pg8::Gemm g{(const bf16_t*)(ws + WS_U), (const bf16_t*)(ws + WS_WDN), NB * SEQ, D, FF, 1}; pg8::StaticOrder S; S.init(NB * SEQ, D, F.G, (int)blockIdx.x);
        { pg8::Unit uu; for (int i = 0; S.next(i, uu); ++i) ffn_fix_rows(F, args, uu.pm); }
        VM_WAIT(); __syncthreads();
        pg8::EpiDown E{args.out, (const bf16_t*)(ws + WS_H1B)};
        pg8::gemm_phase<pg8::EpiDown, pg8::StaticOrder, PG8_ALIGN, PG8_SP2>(F.lds + RING_OFF, g, S, E);
    }
#undef IN
#undef BOTH
}

static int g_grid = 0;
static void launch_mega(const Args& base, int lo, int hi, int region, hipStream_t stream) {
    Args a = base; a.ph_lo = lo; a.ph_hi = hi; a.bar_region = region; a.pad = 0;
    void* params[] = {(void*)&a};
    const hipError_t e = hipLaunchCooperativeKernel((const void*)mega_fwd, dim3(g_grid), dim3(NWAVES * 64), params, LDS_BYTES, stream);
    if (e != hipSuccess) fprintf(stderr, "kernel_launch: cooperative launch [%d,%d) failed: %s (grid %d)\n", lo, hi, hipGetErrorString(e), g_grid);
}
extern "C" void kernel_launch(void* const* d_in, const int* in_sizes, int n_in, void* d_out, int out_size, void* d_ws, size_t ws_size, hipStream_t stream) {
    if (g_grid == 0) {
        if (n_in != 25 || in_sizes[0] != NB * SEQ * D || out_size != NB * SEQ * D || ws_size < 256 * MiB) { fprintf(stderr, "kernel_launch: unexpected shapes n_in %d in0 %d out %d ws %zu\n", n_in, n_in > 0 ? in_sizes[0] : -1, out_size, ws_size); g_grid = -1; return; }
        int dev = 0, cus = 0, per_cu = 0;
        if (hipGetDevice(&dev) != hipSuccess || hipDeviceGetAttribute(&cus, hipDeviceAttributeMultiprocessorCount, dev) != hipSuccess) { g_grid = -1; return; }
        if (hipFuncSetAttribute((const void*)mega_fwd, hipFuncAttributeMaxDynamicSharedMemorySize, LDS_BYTES) != hipSuccess) { fprintf(stderr, "kernel_launch: hipFuncSetAttribute failed\n"); g_grid = -1; return; }
        if (hipOccupancyMaxActiveBlocksPerMultiprocessor(&per_cu, (const void*)mega_fwd, NWAVES * 64, LDS_BYTES) != hipSuccess || per_cu < 1) { fprintf(stderr, "kernel_launch: occupancy query says %d\n", per_cu); per_cu = 1; }
        (void)hipGetLastError();
        g_grid = cus;
    }
    if (g_grid < 0) return;
    unsigned char* ws = (unsigned char*)d_ws; float* out = (float*)d_out;
    if (hipMemsetAsync(ws + WS_CTL, 0, CTL_ZERO_BYTES, stream) != hipSuccess) { fprintf(stderr, "kernel_launch: memset failed\n"); return; }
    Args a{}; for (int i = 0; i < 25; ++i) a.in[i] = (const float*)d_in[i]; a.out = out; a.ws = ws;
    launch_mega(a, 0, 10, 0, stream);
}
```
